# Optimizing an MI355X kernel written in HIP

```python
import math
import jax, jax.numpy as jnp
from jax import lax
import numpy as np

D_MODEL = 1024
BATCH = 16
SEQ = 2048
DEPTH = 2

N_META = 16
ROPE_THETA = 10000.0
NORM_EPS = 1e-6

ATT_HEAD_DIM = 64
ATT_HEADS = D_MODEL // (2 * ATT_HEAD_DIM)
ATT_QK_W = ATT_HEADS * 2 * ATT_HEAD_DIM
ATT_V_DIM = 2 * ATT_HEAD_DIM
ATT_W = ATT_HEADS * ATT_V_DIM
ATT_BLOCK = 128

RWKV_HEAD_DIM = 64
RWKV_HEADS = D_MODEL // RWKV_HEAD_DIM
RWKV_W = RWKV_HEADS * RWKV_HEAD_DIM
RWKV_DECAY_RANK = 64
RWKV_A_RANK = 64
RWKV_GN_EPS = 64e-5
RWKV_IN_W = 4 * RWKV_W + RWKV_DECAY_RANK + RWKV_A_RANK
RWKV_SPLITS = (RWKV_W, 2 * RWKV_W, 3 * RWKV_W, 4 * RWKV_W, 4 * RWKV_W + RWKV_DECAY_RANK)

HGRN_EXPAND = 128
HGRN_HEADS = D_MODEL // HGRN_EXPAND
HGRN_W = HGRN_HEADS * HGRN_EXPAND
HGRN_V_DIM = HGRN_W // HGRN_HEADS
HGRN_CHUNK = 64

N_BRANCH = 3
IN_WIDTHS = (ATT_QK_W, ATT_QK_W, ATT_W, ATT_W, RWKV_IN_W, HGRN_W, HGRN_W, HGRN_W, HGRN_W, N_BRANCH * D_MODEL)
IN_SPLITS = tuple(sum(IN_WIDTHS[:i + 1]) for i in range(len(IN_WIDTHS) - 1))
IN_W = sum(IN_WIDTHS)

kernel_name = "hybrid_diffattn_rwkv7_hgrn2_gated_merge"


def rms_norm(x, w, eps=NORM_EPS):
    xf = x.astype(jnp.float32)
    y = xf * lax.rsqrt(jnp.mean(xf * xf, axis=-1, keepdims=True) + eps)
    return (y * w.astype(jnp.float32)).astype(x.dtype)


def head_layer_norm(x, w, b, eps):
    xf = x.astype(jnp.float32)
    mu = jnp.mean(xf, axis=-1, keepdims=True)
    var = jnp.mean(jnp.square(xf - mu), axis=-1, keepdims=True)
    y = (xf - mu) * lax.rsqrt(var + eps)
    return y * w.reshape(x.shape[-2:]).astype(jnp.float32) + b.reshape(x.shape[-2:]).astype(jnp.float32)


def rotary_tables(n_pos, dim, dtype):
    inv = 1.0 / (ROPE_THETA ** (jnp.arange(0, dim, 2, dtype=jnp.float32) / dim))
    ang = jnp.arange(n_pos, dtype=jnp.float32)[:, None] * inv[None, :]
    ang = jnp.concatenate([ang, ang], axis=-1)
    return jnp.cos(ang).astype(dtype), jnp.sin(ang).astype(dtype)


def apply_rope(x, cos, sin):
    c = cos[None, :, None, None, :]
    s = sin[None, :, None, None, :]
    x1, x2 = jnp.split(x, 2, axis=-1)
    return x * c + jnp.concatenate([-x2, x1], axis=-1) * s


def token_shift(z):
    return jnp.pad(z[:, :-1], ((0, 0), (1, 0), (0, 0)))


def diff_attention(q, k, v, lam, cos, sin):
    B, L = q.shape[0], q.shape[1]
    pad = (-L) % ATT_BLOCK
    P = L + pad
    q = apply_rope(q, cos, sin)
    k = apply_rope(k, cos, sin)
    q = jnp.pad(jnp.transpose(q, (0, 2, 3, 1, 4)), ((0, 0), (0, 0), (0, 0), (pad, 0), (0, 0)))
    k = jnp.pad(jnp.transpose(k, (0, 2, 3, 1, 4)), ((0, 0), (0, 0), (0, 0), (pad, 0), (0, 0)))
    v = jnp.pad(jnp.transpose(v, (0, 2, 1, 3)), ((0, 0), (0, 0), (pad, 0), (0, 0)))
    key_pos = jnp.arange(P)
    scale = ATT_HEAD_DIM ** -0.5

    def block(n):
        start = n * ATT_BLOCK
        qb = lax.dynamic_slice_in_dim(q, start, ATT_BLOCK, axis=3)
        s = jnp.einsum('bhgqd,bhgkd->bhgqk', qb, k, preferred_element_type=jnp.float32) * scale
        q_pos = start + jnp.arange(ATT_BLOCK)
        allowed = (key_pos[None, :] <= q_pos[:, None]) & (key_pos[None, :] >= pad)
        p = jax.nn.softmax(jnp.where(allowed, s, -1e30), axis=-1)
        w = p[:, :, 0] - lam * p[:, :, 1]
        return jnp.einsum('bhqk,bhkv->bhqv', w.astype(v.dtype), v)

    o = lax.map(block, jnp.arange(P // ATT_BLOCK))
    o = jnp.transpose(o, (1, 0, 3, 2, 4)).reshape(B, P, ATT_HEADS, ATT_V_DIM)
    return o[:, pad:]


def rwkv7_recurrence(r, w, k, v, a, b):
    B, L, H, N = r.shape

    def step(S, inp):
        r_t, w_t, k_t, v_t, a_t, b_t = inp
        sa = jnp.einsum('bhvk,bhk->bhv', S, a_t)
        S = S * w_t[:, :, None, :] + sa[..., None] * b_t[:, :, None, :] + v_t[..., None] * k_t[:, :, None, :]
        return S, jnp.einsum('bhvk,bhk->bhv', S, r_t)

    xs = tuple(jnp.moveaxis(t.astype(jnp.float32), 1, 0) for t in (r, w, k, v, a, b))
    _, o = lax.scan(step, jnp.zeros((B, H, N, N), jnp.float32), xs)
    return jnp.moveaxis(o, 0, 1)


def hgrn2_chunked(q, k, v, log_f):
    B, L, H, K = q.shape
    V = v.shape[-1]
    C = HGRN_CHUNK
    pad = (-L) % C
    P = L + pad
    n = P // C

    def chunks(t):
        t = jnp.pad(t.astype(jnp.float32), ((0, 0), (pad, 0), (0, 0), (0, 0)))
        return t.reshape(B, n, C, H, t.shape[-1]).transpose(1, 0, 3, 2, 4)

    causal = jnp.tril(jnp.ones((C, C), dtype=bool))

    def step(S, inp):
        qc, kc, vc, gc = inp
        lam = jnp.cumsum(gc, axis=2)
        o_inter = jnp.einsum('bhtk,bhkv->bhtv', qc * jnp.exp(lam), S)
        rel = lam[:, :, :, None, :] - lam[:, :, None, :, :]
        decay = jnp.exp(jnp.where(causal[:, :, None], rel, -jnp.inf))
        att = jnp.einsum('bhtk,bhsk,bhtsk->bhts', qc, kc, decay)
        o = o_inter + jnp.einsum('bhts,bhsv->bhtv', att, vc)
        lam_end = lam[:, :, -1:, :]
        S = jnp.exp(lam_end[:, :, 0, :])[..., None] * S + jnp.einsum('bhsk,bhsv->bhkv', kc * jnp.exp(lam_end - lam), vc)
        return S, o

    _, o = lax.scan(step, jnp.zeros((B, H, K, V), jnp.float32), (chunks(q), chunks(k), chunks(v), chunks(log_f)))
    o = o.transpose(1, 0, 3, 2, 4).reshape(B, P, H, V)
    return o[:, pad:]


def hybrid_layer(h, l, cos, sin, pre_w, post_w, w_in, lq1, lk1, lq2, lk2, att_norm_w,
                 rwkv_mu, rwkv_w0, rwkv_w_up, rwkv_a0, rwkv_a_up, rwkv_k_k, rwkv_k_a, rwkv_r_k,
                 rwkv_gn_w, rwkv_gn_b, hgrn_lb, hgrn_norm_w, w_att_out, w_rwkv_out, w_hgrn_out, w_o):
    B, L, _ = h.shape
    f32 = jnp.float32
    u = rms_norm(h, pre_w)
    z = u @ w_in
    aq, ak, av, ag, rz, hq, hf, hi, hg, mg = jnp.split(z, IN_SPLITS, axis=-1)

    lam_init = 0.8 - 0.6 * math.exp(-0.3 * l)
    lam = (jnp.exp(jnp.sum(lq1.astype(f32) * lk1.astype(f32))) - jnp.exp(jnp.sum(lq2.astype(f32) * lk2.astype(f32))) + lam_init)
    o_att = diff_attention(aq.reshape(B, L, ATT_HEADS, 2, ATT_HEAD_DIM), ak.reshape(B, L, ATT_HEADS, 2, ATT_HEAD_DIM),
                           av.reshape(B, L, ATT_HEADS, ATT_V_DIM), lam, cos, sin)
    o_att = rms_norm(o_att, att_norm_w) * (1.0 - lam_init)
    o_att = (o_att.reshape(B, L, ATT_W) * jax.nn.silu(ag)).astype(h.dtype)

    rz = rz + (token_shift(rz) - rz) * rwkv_mu
    rr, rk, rv, rg, rwd, rad = jnp.split(rz, RWKV_SPLITS, axis=-1)
    w_log = -jax.nn.softplus(-(rwkv_w0 + jnp.tanh(rwd) @ rwkv_w_up)) - 0.5
    decay = jnp.exp(-jnp.exp(w_log.astype(f32)))
    a = jax.nn.sigmoid((rwkv_a0 + rad @ rwkv_a_up).astype(f32))
    heads = lambda t: t.reshape(B, L, RWKV_HEADS, RWKV_HEAD_DIM)
    kk = heads((rk * rwkv_k_k).astype(f32))
    kk = kk / jnp.maximum(jnp.sqrt(jnp.sum(kk * kk, axis=-1, keepdims=True)), 1e-12)
    rk = rk.astype(f32) * (1.0 + (a - 1.0) * rwkv_k_a.astype(f32))
    r_h, k_h, v_h, a_h = heads(rr.astype(f32)), heads(rk), heads(rv.astype(f32)), heads(a)
    o = rwkv7_recurrence(r_h, heads(decay), k_h, v_h, -kk, kk * a_h)
    o = head_layer_norm(o, rwkv_gn_w, rwkv_gn_b, RWKV_GN_EPS)
    o = o + jnp.sum(r_h * k_h * rwkv_r_k.astype(f32), axis=-1, keepdims=True) * v_h
    o_rwkv = (o.reshape(B, L, RWKV_W) * jax.nn.silu(rg.astype(f32))).astype(h.dtype)

    lb = hgrn_lb.reshape(HGRN_HEADS, HGRN_EXPAND)
    f_gate = lb + (1.0 - lb) * jax.nn.sigmoid(hf.astype(f32).reshape(B, L, HGRN_HEADS, HGRN_EXPAND))
    o = hgrn2_chunked(jax.nn.silu(hq).reshape(B, L, HGRN_HEADS, HGRN_EXPAND), 1.0 - f_gate,
                      hi.reshape(B, L, HGRN_HEADS, HGRN_V_DIM), jnp.log(f_gate))
    o = rms_norm(o, hgrn_norm_w) * jax.nn.silu(hg.astype(f32)).reshape(B, L, HGRN_HEADS, HGRN_V_DIM)
    o_hgrn = o.reshape(B, L, HGRN_W).astype(h.dtype)

    g_att, g_rwkv, g_hgrn = jnp.split(jax.nn.sigmoid(mg), N_BRANCH, axis=-1)
    y = g_att * (o_att @ w_att_out) + g_rwkv * (o_rwkv @ w_rwkv_out) + g_hgrn * (o_hgrn @ w_hgrn_out)
    return h + rms_norm(y @ w_o, post_w)


def setup_inputs(seed: int = 0) -> dict:
    key = jax.random.key(seed)
    ks = jax.random.split(key, 26)
    f32 = jnp.float32

    def nrm(k, shape, scale):
        return jax.random.normal(k, shape, f32) * scale

    return {
        "x": nrm(ks[0], (BATCH, SEQ, D_MODEL), 1.0),
        "meta_tokens": nrm(ks[1], (N_META, D_MODEL), 1.0),
        "pre_norm_w": 1.0 + nrm(ks[2], (DEPTH, D_MODEL), 0.05),
        "post_norm_w": 1.0 + nrm(ks[3], (DEPTH, D_MODEL), 0.05),
        "w_in": nrm(ks[4], (DEPTH, D_MODEL, IN_W), D_MODEL ** -0.5),
        "lambda_q1": nrm(ks[5], (DEPTH, ATT_HEAD_DIM), 0.1),
        "lambda_k1": nrm(ks[6], (DEPTH, ATT_HEAD_DIM), 0.1),
        "lambda_q2": nrm(ks[7], (DEPTH, ATT_HEAD_DIM), 0.1),
        "lambda_k2": nrm(ks[8], (DEPTH, ATT_HEAD_DIM), 0.1),
        "att_norm_w": 1.0 + nrm(ks[9], (DEPTH, ATT_V_DIM), 0.05),
        "rwkv_mu": jax.random.uniform(ks[10], (DEPTH, RWKV_IN_W), f32),
        "rwkv_w0": jax.random.uniform(ks[11], (DEPTH, RWKV_W), f32, minval=-6.0, maxval=1.0),
        "rwkv_w_up": nrm(ks[12], (DEPTH, RWKV_DECAY_RANK, RWKV_W), 0.5 * RWKV_DECAY_RANK ** -0.5),
        "rwkv_a0": nrm(ks[13], (DEPTH, RWKV_W), 0.1),
        "rwkv_a_up": nrm(ks[14], (DEPTH, RWKV_A_RANK, RWKV_W), 0.5 * RWKV_A_RANK ** -0.5),
        "rwkv_k_k": 0.85 + nrm(ks[15], (DEPTH, RWKV_W), 0.05),
        "rwkv_k_a": 1.0 + nrm(ks[16], (DEPTH, RWKV_W), 0.05),
        "rwkv_r_k": nrm(ks[17], (DEPTH, RWKV_HEADS, RWKV_HEAD_DIM), 0.1),
        "rwkv_gn_w": 1.0 + nrm(ks[18], (DEPTH, RWKV_W), 0.05),
        "rwkv_gn_b": nrm(ks[19], (DEPTH, RWKV_W), 0.01),
        "hgrn_lower_bounds": nrm(ks[20], (DEPTH, HGRN_W), 0.1),
        "hgrn_norm_w": 1.0 + nrm(ks[21], (DEPTH, HGRN_V_DIM), 0.05),
        "w_att_out": nrm(ks[22], (DEPTH, ATT_W, D_MODEL), ATT_W ** -0.5),
        "w_rwkv_out": nrm(ks[23], (DEPTH, RWKV_W, D_MODEL), RWKV_W ** -0.5),
        "w_hgrn_out": nrm(ks[24], (DEPTH, HGRN_W, D_MODEL), HGRN_W ** -0.5),
        "w_o": nrm(ks[25], (DEPTH, D_MODEL, D_MODEL), D_MODEL ** -0.5),
    }


def reference(x, meta_tokens, pre_norm_w, post_norm_w, w_in, lambda_q1, lambda_k1, lambda_q2, lambda_k2,
              att_norm_w, rwkv_mu, rwkv_w0, rwkv_w_up, rwkv_a0, rwkv_a_up, rwkv_k_k, rwkv_k_a, rwkv_r_k,
              rwkv_gn_w, rwkv_gn_b, hgrn_lower_bounds, hgrn_norm_w, w_att_out, w_rwkv_out, w_hgrn_out, w_o):
    B = x.shape[0]
    meta = jnp.broadcast_to(meta_tokens[None].astype(x.dtype), (B, N_META, D_MODEL))
    h = jnp.concatenate([meta, x], axis=1)
    L = h.shape[1]
    cos, sin = rotary_tables(L, ATT_HEAD_DIM, x.dtype)
    lbs = jnp.cumsum(jax.nn.softmax(hgrn_lower_bounds.astype(jnp.float32), axis=0), axis=0)
    lbs = lbs - lbs[0]
    for l in range(DEPTH):
        h = hybrid_layer(h, l, cos, sin, pre_norm_w[l], post_norm_w[l], w_in[l],
                         lambda_q1[l], lambda_k1[l], lambda_q2[l], lambda_k2[l], att_norm_w[l],
                         rwkv_mu[l], rwkv_w0[l], rwkv_w_up[l], rwkv_a0[l], rwkv_a_up[l], rwkv_k_k[l],
                         rwkv_k_a[l], rwkv_r_k[l], rwkv_gn_w[l], rwkv_gn_b[l], lbs[l], hgrn_norm_w[l],
                         w_att_out[l], w_rwkv_out[l], w_hgrn_out[l], w_o[l])
    return h[:, N_META:]
```

```cpp
#include <hip/hip_runtime.h>
#include <hip/hip_cooperative_groups.h>
#include <cstdio>
namespace cg = cooperative_groups;

typedef unsigned short bf16_t;
typedef short bf16x8 __attribute__((ext_vector_type(8)));
typedef short bf16x4 __attribute__((ext_vector_type(4)));
typedef float f32x4 __attribute__((ext_vector_type(4)));
typedef float f32x16 __attribute__((ext_vector_type(16)));
typedef unsigned u32x2 __attribute__((ext_vector_type(2)));
typedef unsigned u32x4 __attribute__((ext_vector_type(4)));

#ifndef ONE_LAUNCH
#define ONE_LAUNCH 0
#endif

constexpr int DM = 1024, NB = 16, SEQ = 2048, NMETA = 16, LL = 2064, INW = 15488, ZS = 15616;
constexpr int GB = 4, NG = 4, MG = GB * LL;
constexpr int NTH = 512;
constexpr int LDS_BYTES = 131072;
constexpr int C_AQ = 0, C_AK = 1024, C_AV = 2048, C_AG = 3072, C_RR = 4096, C_RK = 5120, C_RV = 6144, C_RG = 7168,
              C_RWD = 8192, C_RAD = 8256, C_HQ = 8320, C_HF = 9344, C_HI = 10368, C_HG = 11392, C_MG = 12416;
constexpr size_t WS_WIN = 0;
constexpr size_t WS_WOUT = WS_WIN + 2ull * ZS * 1024 * 2;
constexpr size_t WOUT_L = 6ull * 1024 * 1024 * 2;
constexpr size_t WS_Z = WS_WOUT + 2 * WOUT_L;
constexpr size_t WS_U = WS_Z + (size_t)MG * ZS * 2;
constexpr size_t WS_P = WS_U + (size_t)MG * 1024 * 2;
constexpr size_t P_ARR = (size_t)MG * 1024 * 2;
constexpr size_t WS_PW = WS_P + 5 * P_ARR;
constexpr size_t WS_PS = WS_PW + (size_t)MG * 1024 * 4;
constexpr size_t WS_HM = WS_PS + (size_t)MG * 16 * 4 * 4;
constexpr size_t WS_END = WS_HM + 16ull * 16 * 1024 * 4;
constexpr size_t WS_GATED = WS_P;
constexpr size_t WS_T = WS_P + (size_t)MG * 3072 * 2;
static_assert(WS_T + (size_t)MG * 1024 * 4 <= WS_PS, "alias overflow");

struct Params {
    const float* x; const float* meta; const float* pre_w; const float* post_w; const float* w_in;
    const float* lq1; const float* lk1; const float* lq2; const float* lk2; const float* att_norm_w;
    const float* mu; const float* w0; const float* w_up; const float* a0; const float* a_up; const float* k_k; const float* k_a; const float* r_k;
    const float* gn_w; const float* gn_b; const float* hlb; const float* hnw;
    const float* w_att_out; const float* w_rwkv_out; const float* w_hgrn_out; const float* w_o;
    float* out; unsigned char* ws;
};

__device__ __forceinline__ bf16_t f2bf(float f) { unsigned u = __float_as_uint(f); u += 0x7fffu + ((u >> 16) & 1u); return (bf16_t)(u >> 16); }
__device__ __forceinline__ float bf2f(bf16_t h) { return __uint_as_float(((unsigned)h) << 16); }
__device__ __forceinline__ unsigned pk2(float lo, float hi) { unsigned r; asm("v_cvt_pk_bf16_f32 %0, %1, %2" : "=v"(r) : "v"(lo), "v"(hi)); return r; }
__device__ __forceinline__ float lo2f(unsigned u) { return __uint_as_float(u << 16); }
__device__ __forceinline__ float hi2f(unsigned u) { return __uint_as_float(u & 0xffff0000u); }
__device__ __forceinline__ float sigm(float x) { return 1.0f / (1.0f + __expf(-x)); }
__device__ __forceinline__ float silu(float x) { return x / (1.0f + __expf(-x)); }
__device__ __forceinline__ float wsum(float v) {
#pragma unroll
    for (int o = 1; o < 64; o <<= 1) v += __shfl_xor(v, o);
    return v;
}
__device__ __forceinline__ f32x16 mfma32(bf16x8 a, bf16x8 b, f32x16 c) { return __builtin_amdgcn_mfma_f32_32x32x16_bf16(a, b, c, 0, 0, 0); }
__device__ __forceinline__ bf16x8 pack8(const f32x16& x, int s) {
    u32x4 w; w.x = pk2(x[8 * s + 0], x[8 * s + 1]); w.y = pk2(x[8 * s + 2], x[8 * s + 3]); w.z = pk2(x[8 * s + 4], x[8 * s + 5]); w.w = pk2(x[8 * s + 6], x[8 * s + 7]);
    return __builtin_bit_cast(bf16x8, w);
}
__device__ __forceinline__ bf16x8 ld44(const bf16_t* p0, const bf16_t* p1) {
    u32x2 a = *(const u32x2*)p0, b = *(const u32x2*)p1; u32x4 w; w.x = a.x; w.y = a.y; w.z = b.x; w.w = b.y; return __builtin_bit_cast(bf16x8, w);
}

__device__ __forceinline__ const float* h_in_row(const Params& p, int l, int b, int t) {
    if (l == 0) return t < NMETA ? p.meta + (size_t)t * DM : p.x + ((size_t)b * SEQ + (t - NMETA)) * DM;
    return t < NMETA ? (const float*)(p.ws + WS_HM) + ((size_t)b * 16 + t) * DM : p.out + ((size_t)b * SEQ + (t - NMETA)) * DM;
}

constexpr int P0_IN_TILES = 16 * 244, P0_PER_LAYER = P0_IN_TILES + 4 * 256;
__device__ void p0_item(const Params& p, int item, float* lds) {
    const int l = item / P0_PER_LAYER; int r = item % P0_PER_LAYER;
    const float* src; bf16_t* dst; int Nsrc, ldd, copies, kt, nt;
    if (r < P0_IN_TILES) { src = p.w_in + (size_t)l * 1024 * INW; Nsrc = INW; dst = (bf16_t*)(p.ws + WS_WIN) + (size_t)l * ZS * 1024; ldd = 1024; copies = 1; kt = r / 244; nt = r % 244; }
    else { r -= P0_IN_TILES; const int mtx = r >> 8; r &= 255; kt = r >> 4; nt = r & 15; Nsrc = 1024;
        const float* s0 = mtx == 0 ? p.w_att_out : mtx == 1 ? p.w_rwkv_out : mtx == 2 ? p.w_hgrn_out : p.w_o; src = s0 + (size_t)l * 1024 * 1024;
        bf16_t* wl = (bf16_t*)(p.ws + WS_WOUT + (size_t)l * WOUT_L);
        if (mtx < 3) { dst = wl + (size_t)mtx * 1024 * 1024; ldd = 1024; copies = 1; } else { dst = wl + 3ull * 1024 * 1024; ldd = 3072; copies = 3; } }
    for (int idx = threadIdx.x; idx < 4096; idx += NTH) { const int kk = idx >> 6, nn = idx & 63, n = nt * 64 + nn;
        lds[nn * 65 + kk] = n < Nsrc ? src[(size_t)(kt * 64 + kk) * Nsrc + n] : 0.f; }
    __syncthreads();
    for (int idx = threadIdx.x; idx < 4096; idx += NTH) { const int nn = idx >> 6, kk = idx & 63; const bf16_t v = f2bf(lds[nn * 65 + kk]);
        for (int c = 0; c < copies; ++c) dst[(size_t)(nt * 64 + nn) * ldd + c * 1024 + kt * 64 + kk] = v; }
    __syncthreads();
}

__device__ void pn_phase(const Params& p, int l, int g) {
    const int wave = threadIdx.x >> 6, lane = threadIdx.x & 63;
    bf16_t* U = (bf16_t*)(p.ws + WS_U); const float* pw = p.pre_w + l * DM;
    for (int m = blockIdx.x * 8 + wave; m < MG; m += gridDim.x * 8) {
        const int b = g * GB + m / LL, t = m % LL; const float* h = h_in_row(p, l, b, t);
        f32x4 v[4]; float ss = 0.f;
#pragma unroll
        for (int i = 0; i < 4; ++i) { v[i] = *(const f32x4*)(h + (lane + 64 * i) * 4); ss += v[i][0] * v[i][0] + v[i][1] * v[i][1] + v[i][2] * v[i][2] + v[i][3] * v[i][3]; }
        ss = wsum(ss); const float rn = rsqrtf(ss * (1.0f / DM) + 1e-6f);
#pragma unroll
        for (int i = 0; i < 4; ++i) { const f32x4 w = *(const f32x4*)(pw + (lane + 64 * i) * 4); u32x2 o; o.x = pk2(v[i][0] * rn * w[0], v[i][1] * rn * w[1]); o.y = pk2(v[i][2] * rn * w[2], v[i][3] * rn * w[3]);
            *(u32x2*)(U + (size_t)m * DM + (lane + 64 * i) * 4) = o; }
    }
}

constexpr int BK = 64, HALF = 128, HT = HALF * BK;
__device__ __forceinline__ int lds_byte(int r, int c) { int st = (r >> 4) * 2 + (c >> 5), rr = r & 15, cc = c & 31, ob = rr * 64 + cc * 2; return st * 1024 + (ob ^ (((ob >> 9) & 1) << 5)); }
__device__ __forceinline__ void stage_rc(int b, int& R, int& C) { int st = b / 1024, sb = b % 1024, swz = sb ^ (((sb >> 9) & 1) << 5); R = (st >> 1) * 16 + swz / 64; C = (st & 1) * 32 + (swz % 64) / 2; }

#define LAS __attribute__((address_space(3)))
template <class Epi>
__device__ __forceinline__ void gemm_unit(const bf16_t* A, int lda, int M, const bf16_t* Bt, int ldb, int nt, int brow, int bcol, unsigned char* shm_, const Epi& epi) {
    LAS unsigned char* lds = (LAS unsigned char*)shm_;
    const int tid = threadIdx.x, wid = __builtin_amdgcn_readfirstlane(tid >> 6), lane = tid & 63, wr = wid >> 2, wc = wid & 3, fr = lane & 15, fq = lane >> 4;
    unsigned voffA[2], voffB[2];
#pragma unroll
    for (int i = 0; i < 2; ++i) { int R, C; stage_rc(tid * 16 + i * 8192, R, C); voffA[i] = (unsigned)(R * lda + C) * 2u; voffB[i] = (unsigned)(R * ldb + C) * 2u; }
    const size_t kstep = (size_t)(BK * 2), hA = (size_t)HALF * lda * 2, hB = (size_t)HALF * ldb * 2;
    const unsigned ldsw = (unsigned)wid * 1024u;
    const int aoff = lds_byte(wr * 64 + fr, fq * 8), boff = lds_byte(wc * 32 + fr, fq * 8);
    const char* cA = (const char*)(A + (size_t)brow * lda); const char* cB = (const char*)(Bt + (size_t)bcol * ldb);
#define SA(b, h) (((b) * 2 + (h)) * (HT * 2))
#define SB(b, h) ((4 + (b) * 2 + (h)) * (HT * 2))
#define STAGE(bufoff, gbase, voff) do { _Pragma("unroll") for (int _i = 0; _i < 2; ++_i) \
        __builtin_amdgcn_global_load_lds((const unsigned*)((const char*)(gbase) + (voff)[_i]), (LAS unsigned*)(lds + (bufoff) + ldsw + _i * 8192), 16, 0, 0); } while (0)
#define LDA(dst, b, h) do { _Pragma("unroll") for (int m = 0; m < 4; ++m) _Pragma("unroll") for (int k = 0; k < 2; ++k) dst[m][k] = *(const LAS bf16x8*)(lds + SA(b, h) + aoff + m * 2048 + k * 1024); } while (0)
#define LDB(dst, b, h) do { _Pragma("unroll") for (int n = 0; n < 2; ++n) _Pragma("unroll") for (int k = 0; k < 2; ++k) dst[n][k] = *(const LAS bf16x8*)(lds + SB(b, h) + boff + n * 2048 + k * 1024); } while (0)
#define MMA(ai, bj, At_, Bt_) do { __builtin_amdgcn_s_setprio(1); _Pragma("unroll") for (int m = 0; m < 4; ++m) _Pragma("unroll") for (int n = 0; n < 2; ++n) _Pragma("unroll") for (int k = 0; k < 2; ++k) \
      acc[ai][bj][m][n] = __builtin_amdgcn_mfma_f32_16x16x32_bf16(Bt_[n][k], At_[m][k], acc[ai][bj][m][n], 0, 0, 0); \
    __builtin_amdgcn_s_setprio(0); } while (0)
#define WAIT_V(n) asm volatile("s_waitcnt vmcnt(" #n ")" ::: "memory")
#define WAIT_L(n) asm volatile("s_waitcnt lgkmcnt(" #n ")" ::: "memory")
#define BAR __builtin_amdgcn_s_barrier()
#define SCHED __builtin_amdgcn_sched_barrier(0)
    f32x4 acc[2][2][4][2];
#pragma unroll
    for (int a = 0; a < 2; ++a)
#pragma unroll
        for (int b = 0; b < 2; ++b)
#pragma unroll
            for (int m = 0; m < 4; ++m)
#pragma unroll
                for (int n = 0; n < 2; ++n) acc[a][b][m][n] = (f32x4){0.f, 0.f, 0.f, 0.f};
    bf16x8 At[4][2], B0[2][2], B1[2][2];
    STAGE(SB(0, 0), cB, voffB); STAGE(SA(0, 0), cA, voffA); STAGE(SB(0, 1), cB + hB, voffB); STAGE(SA(0, 1), cA + hA, voffA);
    if (wr == 1) BAR;
    WAIT_V(4); BAR;
    STAGE(SB(1, 0), cB + kstep, voffB); STAGE(SA(1, 0), cA + kstep, voffA); STAGE(SB(1, 1), cB + hB + kstep, voffB);
    WAIT_V(6); BAR;
    for (int t = 0; t < nt - 2; t += 2) {
        const char* a1 = cA + (size_t)(t + 1) * kstep; const char* a2 = a1 + kstep; const char* b2 = cB + (size_t)(t + 2) * kstep; const char* a3 = a2 + kstep; const char* b3 = b2 + kstep;
        LDB(B0, 0, 0); SCHED; LDA(At, 0, 0); STAGE(SA(1, 1), a1 + hA, voffA);
        WAIT_L(8); BAR; WAIT_L(0); MMA(0, 0, At, B0); BAR; SCHED;
        LDB(B1, 0, 1); STAGE(SB(0, 0), b2, voffB);
        BAR; WAIT_L(0); MMA(0, 1, At, B1); BAR;
        LDA(At, 0, 1); STAGE(SA(0, 0), a2, voffA);
        BAR; WAIT_L(0); MMA(1, 0, At, B0); BAR; SCHED;
        STAGE(SB(0, 1), b2 + hB, voffB);
        WAIT_V(6); BAR; MMA(1, 1, At, B1); BAR;
        LDB(B0, 1, 0); SCHED; LDA(At, 1, 0); STAGE(SA(0, 1), a2 + hA, voffA);
        WAIT_L(8); BAR; WAIT_L(0); MMA(0, 0, At, B0); BAR; SCHED;
        LDB(B1, 1, 1); STAGE(SB(1, 0), b3, voffB);
        BAR; WAIT_L(0); MMA(0, 1, At, B1); BAR;
        LDA(At, 1, 1); STAGE(SA(1, 0), a3, voffA);
        BAR; WAIT_L(0); MMA(1, 0, At, B0); BAR; SCHED;
        STAGE(SB(1, 1), b3 + hB, voffB);
        WAIT_V(6); BAR; MMA(1, 1, At, B1); BAR;
    }
    { LDB(B0, 0, 0); LDA(At, 0, 0); STAGE(SA(1, 1), cA + (size_t)(nt - 1) * kstep + hA, voffA);
      BAR; WAIT_L(0); MMA(0, 0, At, B0); BAR;
      LDB(B1, 0, 1); BAR; WAIT_L(0); MMA(0, 1, At, B1); BAR;
      LDA(At, 0, 1); WAIT_V(4); BAR; WAIT_L(0); MMA(1, 0, At, B0); MMA(1, 1, At, B1); BAR; }
    { LDB(B0, 1, 0); LDA(At, 1, 0); WAIT_V(2); BAR; WAIT_L(0); MMA(0, 0, At, B0); BAR;
      LDB(B1, 1, 1); WAIT_V(0); BAR; WAIT_L(0); MMA(0, 1, At, B1); BAR;
      LDA(At, 1, 1); BAR; WAIT_L(0); MMA(1, 0, At, B0); MMA(1, 1, At, B1); BAR; }
    if (wr == 0) BAR;
#pragma unroll
    for (int ai = 0; ai < 2; ++ai)
#pragma unroll
        for (int m = 0; m < 4; ++m) { const int row = brow + ai * HALF + wr * 64 + m * 16 + fr;
            if (row < M) {
#pragma unroll
                for (int bj = 0; bj < 2; ++bj)
#pragma unroll
                    for (int n = 0; n < 2; ++n) epi(row, bcol + bj * HALF + wc * 32 + n * 16 + fq * 4, acc[ai][bj][m][n]); } }
    __syncthreads();
#undef SA
#undef SB
#undef STAGE
}

struct EpiZ { bf16_t* Z; __device__ __forceinline__ void operator()(int row, int col, const f32x4& v) const { u32x2 o; o.x = pk2(v[0], v[1]); o.y = pk2(v[2], v[3]); *(u32x2*)(Z + (size_t)row * ZS + col) = o; } };
struct EpiGate { const bf16_t* Z; bf16_t* Gd; int br;
    __device__ __forceinline__ void operator()(int row, int col, const f32x4& v) const {
        const u32x2 g = *(const u32x2*)(Z + (size_t)row * ZS + C_MG + br * 1024 + col); u32x2 o;
        o.x = pk2(v[0] * sigm(lo2f(g.x)), v[1] * sigm(hi2f(g.x))); o.y = pk2(v[2] * sigm(lo2f(g.y)), v[3] * sigm(hi2f(g.y)));
        *(u32x2*)(Gd + (size_t)row * 3072 + br * 1024 + col) = o; } };
struct EpiT { float* T; __device__ __forceinline__ void operator()(int row, int col, const f32x4& v) const { *(f32x4*)(T + (size_t)row * DM + col) = v; } };

__device__ void rope_phase(const Params& p) {
    const int wave = threadIdx.x >> 6, lane = threadIdx.x & 63, d = lane & 31, qk = lane >> 5;
    bf16_t* Z = (bf16_t*)(p.ws + WS_Z);
    const float inv = 1.0f / powf(10000.0f, (float)(2 * d) / 64.0f);
    for (int m = blockIdx.x * 8 + wave; m < MG; m += gridDim.x * 8) {
        const int t = m % LL; const float ang = (float)t * inv; float sn, cs; sincosf(ang, &sn, &cs);
        const float sc = qk == 0 ? 0.125f : 1.0f;
        bf16_t* base = Z + (size_t)m * ZS + qk * 1024 + d;
#pragma unroll 4
        for (int hh = 0; hh < 16; ++hh) { const float x1 = bf2f(base[hh * 64]), x2 = bf2f(base[hh * 64 + 32]);
            base[hh * 64] = f2bf((x1 * cs - x2 * sn) * sc); base[hh * 64 + 32] = f2bf((x2 * cs + x1 * sn) * sc); }
    }
}

__device__ void prep_tile(const Params& p, int l, int tile, float* lds) {
    float* lwd = lds; float* lad = lds + 8 * 64;
    const bf16_t* Z = (const bf16_t*)(p.ws + WS_Z);
    const int tid = threadIdx.x; const float* mu = p.mu + l * 4224;
    for (int e = 0; e < 2; ++e) { const int idx = tid + NTH * e, tok = idx >> 7, j = idx & 127, m = tile * 8 + tok, t = m % LL;
        const float raw = bf2f(Z[(size_t)m * ZS + C_RWD + j]), prev = t > 0 ? bf2f(Z[(size_t)(m - 1) * ZS + C_RWD + j]) : 0.f;
        const float xv = raw + (prev - raw) * mu[4096 + j];
        if (j < 64) lwd[tok * 64 + j] = tanhf(xv); else lad[tok * 64 + j - 64] = xv; }
    __syncthreads();
    float ad[8][2], aa[8][2];
#pragma unroll
    for (int k = 0; k < 8; ++k) { ad[k][0] = ad[k][1] = aa[k][0] = aa[k][1] = 0.f; }
    const float* wup = p.w_up + (size_t)l * 64 * 1024; const float* aup = p.a_up + (size_t)l * 64 * 1024;
    for (int j = 0; j < 64; ++j) { const float wu0 = wup[j * 1024 + tid], wu1 = wup[j * 1024 + tid + 512], au0 = aup[j * 1024 + tid], au1 = aup[j * 1024 + tid + 512];
#pragma unroll
        for (int k = 0; k < 8; ++k) { const float td = lwd[k * 64 + j], ta = lad[k * 64 + j]; ad[k][0] += td * wu0; ad[k][1] += td * wu1; aa[k][0] += ta * au0; aa[k][1] += ta * au1; } }
    bf16_t* Pa = (bf16_t*)(p.ws + WS_P); bf16_t* Pb = Pa + (size_t)MG * 1024; bf16_t* Pk = Pb + (size_t)MG * 1024; bf16_t* Pwr = Pk + (size_t)MG * 1024; bf16_t* Pv = Pwr + (size_t)MG * 1024;
    float* Pw = (float*)(p.ws + WS_PW); float* Ps = (float*)(p.ws + WS_PS);
#pragma unroll
    for (int k = 0; k < 8; ++k) { const int m = tile * 8 + k, t = m % LL; const bf16_t* zr = Z + (size_t)m * ZS; const bf16_t* zp = zr - ZS;
#pragma unroll
        for (int cc = 0; cc < 2; ++cc) { const int c = tid + 512 * cc;
            float r0 = bf2f(zr[C_RR + c]), k0 = bf2f(zr[C_RK + c]), v0 = bf2f(zr[C_RV + c]);
            float rp = 0.f, kp = 0.f, vp = 0.f; if (t > 0) { rp = bf2f(zp[C_RR + c]); kp = bf2f(zp[C_RK + c]); vp = bf2f(zp[C_RV + c]); }
            const float xr = r0 + (rp - r0) * mu[c], xk = k0 + (kp - k0) * mu[1024 + c], xv = v0 + (vp - v0) * mu[2048 + c];
            const float y = -(p.w0[l * 1024 + c] + ad[k][cc]);
            const float sp = y > 20.f ? y : log1pf(__expf(y));
            const float dec = __expf(-__expf(-sp - 0.5f));
            const float a = sigm(p.a0[l * 1024 + c] + aa[k][cc]);
            const float kkr = xk * p.k_k[l * 1024 + c]; const float nrm = sqrtf(wsum(kkr * kkr)); const float kk = kkr / fmaxf(nrm, 1e-12f);
            const float kt = xk * (1.0f + (a - 1.0f) * p.k_a[l * 1024 + c]);
            const float bb = kk * a;
            const float brs = wsum(bb * xr), krs = wsum(kt * xr), bon = wsum(xr * kt * p.r_k[l * 1024 + c]);
            const size_t o = (size_t)m * 1024 + c;
            Pa[o] = f2bf(-kk); Pb[o] = f2bf(bb); Pk[o] = f2bf(kt); Pwr[o] = f2bf(dec * xr); Pv[o] = f2bf(xv); Pw[o] = dec;
            if ((tid & 63) == 0) { float* s = Ps + ((size_t)m * 16 + (c >> 6)) * 4; s[0] = brs; s[1] = krs; s[2] = bon; s[3] = 0.f; } } }
    __syncthreads();
}

__device__ void rwkv_item(const Params& p, int l, int item, float* lds) {
    const int bl = item >> 4, h = item & 15, m0 = bl * LL, tid = threadIdx.x, i = tid >> 3, c8 = tid & 7;
    float* ops = lds;
    float* vv = lds + 5 * 1024;
    float* sc = vv + 1024;
    float* ob = sc + 64;
    const bf16_t* Pa = (const bf16_t*)(p.ws + WS_P); const bf16_t* Pb = Pa + (size_t)MG * 1024; const bf16_t* Pk = Pb + (size_t)MG * 1024; const bf16_t* Pwr = Pk + (size_t)MG * 1024; const bf16_t* Pv = Pwr + (size_t)MG * 1024;
    const float* Pw = (const float*)(p.ws + WS_PW); const float* Ps = (const float*)(p.ws + WS_PS);
    bf16_t* Z = (bf16_t*)(p.ws + WS_Z);
    float S[8];
#pragma unroll
    for (int j = 0; j < 8; ++j) S[j] = 0.f;
    const float gw0 = p.gn_w[l * 1024 + h * 64 + (tid & 31)], gw1 = p.gn_w[l * 1024 + h * 64 + (tid & 31) + 32];
    const float gb0 = p.gn_b[l * 1024 + h * 64 + (tid & 31)], gb1 = p.gn_b[l * 1024 + h * 64 + (tid & 31) + 32];
    const float mg0 = p.mu[l * 4224 + 3072 + h * 64 + (tid & 31)], mg1 = p.mu[l * 4224 + 3072 + h * 64 + (tid & 31) + 32];
    for (int ch = 0; ch < LL / 16; ++ch) {
        for (int e = 0; e < 2; ++e) { const int idx = tid + NTH * e, s = idx >> 6, j = idx & 63; const size_t o = (size_t)(m0 + ch * 16 + s) * 1024 + h * 64 + j;
            ops[0 * 1024 + idx] = Pw[o]; ops[1 * 1024 + idx] = bf2f(Pa[o]); ops[2 * 1024 + idx] = bf2f(Pb[o]); ops[3 * 1024 + idx] = bf2f(Pk[o]); ops[4 * 1024 + idx] = bf2f(Pwr[o]); vv[idx] = bf2f(Pv[o]); }
        if (tid < 64) sc[tid] = Ps[((size_t)(m0 + ch * 16 + (tid >> 2)) * 16 + h) * 4 + (tid & 3)];
        __syncthreads();
#pragma unroll 2
        for (int s = 0; s < 16; ++s) {
            const float* o0 = ops + s * 64 + c8 * 8;
            const f32x4 a0 = *(const f32x4*)(o0 + 1024), a1 = *(const f32x4*)(o0 + 1024 + 4), q0 = *(const f32x4*)(o0 + 4096), q1 = *(const f32x4*)(o0 + 4096 + 4);
            float p1 = S[0] * a0[0] + S[1] * a0[1] + S[2] * a0[2] + S[3] * a0[3] + S[4] * a1[0] + S[5] * a1[1] + S[6] * a1[2] + S[7] * a1[3];
            float p2 = S[0] * q0[0] + S[1] * q0[1] + S[2] * q0[2] + S[3] * q0[3] + S[4] * q1[0] + S[5] * q1[1] + S[6] * q1[2] + S[7] * q1[3];
            p1 += __shfl_xor(p1, 1); p2 += __shfl_xor(p2, 1); p1 += __shfl_xor(p1, 2); p2 += __shfl_xor(p2, 2); p1 += __shfl_xor(p1, 4); p2 += __shfl_xor(p2, 4);
            const float vi = vv[s * 64 + i], brs = sc[s * 4 + 0], krs = sc[s * 4 + 1];
            if (c8 == 0) ob[s * 64 + i] = p2 + p1 * brs + vi * krs;
            const f32x4 w0 = *(const f32x4*)(o0), w1 = *(const f32x4*)(o0 + 4), b0 = *(const f32x4*)(o0 + 2048), b1 = *(const f32x4*)(o0 + 2048 + 4), k0 = *(const f32x4*)(o0 + 3072), k1 = *(const f32x4*)(o0 + 3072 + 4);
#pragma unroll
            for (int j = 0; j < 4; ++j) { S[j] = S[j] * w0[j] + (p1 * b0[j] + vi * k0[j]); S[4 + j] = S[4 + j] * w1[j] + (p1 * b1[j] + vi * k1[j]); }
        }
        __syncthreads();
        { const int tok = tid >> 5, i2 = tid & 31; const float o0 = ob[tok * 64 + i2], o1 = ob[tok * 64 + i2 + 32];
            float sm = o0 + o1;
#pragma unroll
            for (int o = 1; o < 32; o <<= 1) sm += __shfl_xor(sm, o);
            const float mean = sm * (1.0f / 64.0f); const float d0 = o0 - mean, d1 = o1 - mean; float vr = d0 * d0 + d1 * d1;
#pragma unroll
            for (int o = 1; o < 32; o <<= 1) vr += __shfl_xor(vr, o);
            const float rs = rsqrtf(vr * (1.0f / 64.0f) + 64e-5f); const float bon = sc[tok * 4 + 2];
            float y0 = d0 * rs * gw0 + gb0 + bon * vv[tok * 64 + i2], y1 = d1 * rs * gw1 + gb1 + bon * vv[tok * 64 + i2 + 32];
            const int t = ch * 16 + tok; const size_t zr = (size_t)(m0 + t) * ZS + C_RG + h * 64 + i2;
            const float g0 = bf2f(Z[zr]), g1 = bf2f(Z[zr + 32]); float gp0 = 0.f, gp1 = 0.f; if (t > 0) { gp0 = bf2f(Z[zr - ZS]); gp1 = bf2f(Z[zr - ZS + 32]); }
            y0 *= silu(g0 + (gp0 - g0) * mg0); y1 *= silu(g1 + (gp1 - g1) * mg1);
            bf16_t* zo = Z + (size_t)(m0 + t) * ZS + C_RR + h * 64 + i2; zo[0] = f2bf(y0); zo[32] = f2bf(y1); }
        __syncthreads();
    }
}

__device__ void hgrn_item(const Params& p, int l, int item, unsigned char* smem) {
    const int bl = item >> 3, h = item & 7, m0 = bl * LL, tid = threadIdx.x, w = tid >> 6, lane = tid & 63, l31 = lane & 31, hh = lane >> 5;
    float* Gf = (float*)smem; float* Qf = (float*)(smem + 16384); float* Kf = (float*)(smem + 32768); float* dec = (float*)(smem + 49152);
    bf16_t* Qh = (bf16_t*)(smem + 49664); bf16_t* Kc = (bf16_t*)(smem + 58368); bf16_t* KbT = (bf16_t*)(smem + 67072); bf16_t* VT = (bf16_t*)(smem + 77312);
    float* Ob = (float*)(smem + 87552);
    bf16_t* Z = (bf16_t*)(p.ws + WS_Z);
    const int vt = w & 3, kt0 = 2 * (w >> 2);
    f32x16 S[2];
#pragma unroll
    for (int r = 0; r < 16; ++r) { S[0][r] = 0.f; S[1][r] = 0.f; }
    for (int ch = 0; ch < (LL + 31) / 32; ++ch) {
        const int t0 = ch * 32;
        for (int e = 0; e < 8; ++e) { const int idx = tid + NTH * e, tt = idx >> 7, k = idx & 127, t = t0 + tt; const bool valid = t < LL;
            float g = 0.f, q = 0.f, kk = 0.f; bf16_t vb = 0;
            if (valid) { const bf16_t* zr = Z + (size_t)(m0 + t) * ZS + h * 128 + k; const float hq = bf2f(zr[C_HQ]), hf = bf2f(zr[C_HF]); vb = zr[C_HI];
                float lb = 0.f; if (l == 1) { const float x0 = p.hlb[h * 128 + k], x1 = p.hlb[1024 + h * 128 + k]; lb = 1.0f / (1.0f + __expf(x0 - x1)); }
                const float fg = lb + (1.0f - lb) * sigm(hf); g = __logf(fg); q = silu(hq); kk = 1.0f - fg; }
            Gf[idx] = g; Qf[idx] = q; Kf[idx] = kk; VT[k * 40 + tt] = vb; }
        __syncthreads();
        if (tid < 128) { float run = 0.f; for (int tt = 0; tt < 32; ++tt) { run += Gf[tt * 128 + tid]; Gf[tt * 128 + tid] = run; } dec[tid] = __expf(run); }
        __syncthreads();
        for (int e = 0; e < 8; ++e) { const int idx = tid + NTH * e, tt = idx >> 7, k = idx & 127; const float lam = Gf[idx], le = Gf[31 * 128 + k], q = Qf[idx], kk = Kf[idx];
            Qh[tt * 136 + k] = f2bf(q * __expf(lam)); Kc[tt * 136 + k] = f2bf(kk * __expf(-lam)); KbT[k * 40 + tt] = f2bf(kk * __expf(le - lam)); }
        __syncthreads();
        f32x16 O;
#pragma unroll
        for (int r = 0; r < 16; ++r) O[r] = 0.f;
#pragma unroll
        for (int k2 = 0; k2 < 2; ++k2)
#pragma unroll
            for (int s = 0; s < 2; ++s) { const bf16_t* qa = Qh + l31 * 136 + 32 * (kt0 + k2) + 16 * s + 4 * hh; O = mfma32(ld44(qa, qa + 8), pack8(S[k2], s), O); }
        if (w < 4) {
            f32x16 X;
#pragma unroll
            for (int r = 0; r < 16; ++r) X[r] = 0.f;
#pragma unroll
            for (int s8 = 0; s8 < 8; ++s8) X = mfma32(*(const bf16x8*)(Kc + l31 * 136 + 16 * s8 + 8 * hh), *(const bf16x8*)(Qh + l31 * 136 + 16 * s8 + 8 * hh), X);
#pragma unroll
            for (int r = 0; r < 16; ++r) { const int srow = (r & 3) + 8 * (r >> 2) + 4 * hh; if (srow > l31) X[r] = 0.f; }
#pragma unroll
            for (int st = 0; st < 2; ++st) { const bf16_t* vb = VT + (32 * vt + l31) * 40 + 16 * st + 4 * hh; O = mfma32(pack8(X, st), ld44(vb, vb + 8), O); }
        } else {
#pragma unroll
            for (int r = 0; r < 16; ++r) Ob[((r & 3) + 8 * (r >> 2) + 4 * hh) * 132 + 32 * vt + l31] = O[r];
        }
        __syncthreads();
        if (w < 4) {
#pragma unroll
            for (int r = 0; r < 16; ++r) { float* o = Ob + ((r & 3) + 8 * (r >> 2) + 4 * hh) * 132 + 32 * vt + l31; *o = *o + O[r]; }
        }
#pragma unroll
        for (int k2 = 0; k2 < 2; ++k2) { const int kt = kt0 + k2;
#pragma unroll
            for (int r = 0; r < 16; ++r) S[k2][r] *= dec[32 * kt + (r & 3) + 8 * (r >> 2) + 4 * hh];
#pragma unroll
            for (int st = 0; st < 2; ++st) S[k2] = mfma32(*(const bf16x8*)(KbT + (32 * kt + l31) * 40 + 16 * st + 8 * hh), *(const bf16x8*)(VT + (32 * vt + l31) * 40 + 16 * st + 8 * hh), S[k2]); }
        __syncthreads();
        { const int tt = tid >> 4, v0 = (tid & 15) * 8, t = t0 + tt; float o[8]; float ss = 0.f;
#pragma unroll
            for (int j = 0; j < 8; ++j) { o[j] = Ob[tt * 132 + v0 + j]; ss += o[j] * o[j]; }
            ss += __shfl_xor(ss, 1); ss += __shfl_xor(ss, 2); ss += __shfl_xor(ss, 4); ss += __shfl_xor(ss, 8);
            const float rn = rsqrtf(ss * (1.0f / 128.0f) + 1e-6f);
            if (t < LL) { bf16_t* zr = Z + (size_t)(m0 + t) * ZS + h * 128 + v0; const u32x4 gg = *(const u32x4*)(zr + C_HG); const float* nw = p.hnw + l * 128 + v0;
                u32x4 ov; ov.x = pk2(o[0] * rn * nw[0] * silu(lo2f(gg.x)), o[1] * rn * nw[1] * silu(hi2f(gg.x))); ov.y = pk2(o[2] * rn * nw[2] * silu(lo2f(gg.y)), o[3] * rn * nw[3] * silu(hi2f(gg.y)));
                ov.z = pk2(o[4] * rn * nw[4] * silu(lo2f(gg.z)), o[5] * rn * nw[5] * silu(hi2f(gg.z))); ov.w = pk2(o[6] * rn * nw[6] * silu(lo2f(gg.w)), o[7] * rn * nw[7] * silu(hi2f(gg.w)));
                *(u32x4*)(zr + C_HQ) = ov; } }
        __syncthreads();
    }
}

__device__ void attn_item(const Params& p, int l, int item, unsigned char* smem) {
    const int bl = item / 136, rr = item % 136, h = rr / 17, qt = 16 - (rr % 17), q0 = qt * 128, m0 = bl * LL;
    const int tid = threadIdx.x, w = tid >> 6, lane = tid & 63, l31 = lane & 31, hh = lane >> 5, g2 = w >> 2, wq = w & 3;
    bf16_t* Ks = (bf16_t*)smem; bf16_t* Vt = (bf16_t*)(smem + 17408); float* Ex = (float*)(smem + 17408 + 18432);
    bf16_t* Z = (bf16_t*)(p.ws + WS_Z);
    const int qrow = q0 + wq * 32 + l31, qr = qrow < LL ? qrow : LL - 1;
    bf16x8 qf[4];
    { const bf16_t* qp = Z + (size_t)(m0 + qr) * ZS + C_AQ + h * 128 + g2 * 64 + 8 * hh;
#pragma unroll
        for (int s = 0; s < 4; ++s) qf[s] = *(const bf16x8*)(qp + 16 * s); }
    f32x16 O[4];
#pragma unroll
    for (int v = 0; v < 4; ++v)
#pragma unroll
        for (int r = 0; r < 16; ++r) O[v][r] = 0.f;
    float mrun = -1e30f, lrun = 0.f;
    int nkt = (q0 + 128 + 63) / 64; if (nkt > (LL + 63) / 64) nkt = (LL + 63) / 64;
    for (int kt = 0; kt < nkt; ++kt) {
        const int k0 = kt * 64;
        __syncthreads();
        for (int e = 0; e < 2; ++e) { const int idx = tid + NTH * e, key = idx >> 4, c16 = idx & 15; int kr = k0 + key; kr = kr < LL ? kr : LL - 1;
            const bf16_t* zr = Z + (size_t)(m0 + kr) * ZS + h * 128 + c16 * 8;
            *(u32x4*)(Ks + key * 136 + c16 * 8) = *(const u32x4*)(zr + C_AK);
            const bf16x8 vv = *(const bf16x8*)(zr + C_AV);
#pragma unroll
            for (int j = 0; j < 8; ++j) Vt[(c16 * 8 + j) * 72 + key] = (bf16_t)vv[j]; }
        __syncthreads();
        f32x16 X[2];
#pragma unroll
        for (int t2 = 0; t2 < 2; ++t2) {
#pragma unroll
            for (int r = 0; r < 16; ++r) X[t2][r] = 0.f;
#pragma unroll
            for (int s = 0; s < 4; ++s) X[t2] = mfma32(*(const bf16x8*)(Ks + (32 * t2 + l31) * 136 + g2 * 64 + 16 * s + 8 * hh), qf[s], X[t2]); }
        float mx = -1e30f;
#pragma unroll
        for (int t2 = 0; t2 < 2; ++t2)
#pragma unroll
            for (int r = 0; r < 16; ++r) { const int key = k0 + 32 * t2 + (r & 3) + 8 * (r >> 2) + 4 * hh; if (key > qrow) X[t2][r] = -1e30f; mx = fmaxf(mx, X[t2][r]); }
        mx = fmaxf(mx, __shfl_xor(mx, 32));
        const float mnew = fmaxf(mrun, mx), alpha = __expf(mrun - mnew); float sm = 0.f;
#pragma unroll
        for (int t2 = 0; t2 < 2; ++t2)
#pragma unroll
            for (int r = 0; r < 16; ++r) { const float e = __expf(X[t2][r] - mnew); X[t2][r] = e; sm += e; }
        sm += __shfl_xor(sm, 32); lrun = lrun * alpha + sm; mrun = mnew;
#pragma unroll
        for (int v = 0; v < 4; ++v)
#pragma unroll
            for (int r = 0; r < 16; ++r) O[v][r] *= alpha;
#pragma unroll
        for (int t2 = 0; t2 < 2; ++t2)
#pragma unroll
            for (int s = 0; s < 2; ++s) { const bf16x8 pb = pack8(X[t2], s);
#pragma unroll
                for (int v = 0; v < 4; ++v) { const bf16_t* va = Vt + (32 * v + l31) * 72 + 32 * t2 + 16 * s + 4 * hh; O[v] = mfma32(ld44(va, va + 8), pb, O[v]); } }
    }
    const float il = 1.0f / lrun; const int ql = wq * 32 + l31;
    if (g2 == 1) {
#pragma unroll
        for (int v = 0; v < 4; ++v)
#pragma unroll
            for (int r4 = 0; r4 < 4; ++r4) { f32x4 o; o[0] = O[v][4 * r4] * il; o[1] = O[v][4 * r4 + 1] * il; o[2] = O[v][4 * r4 + 2] * il; o[3] = O[v][4 * r4 + 3] * il;
                *(f32x4*)(Ex + ql * 132 + 32 * v + 8 * r4 + 4 * hh) = o; }
    }
    __syncthreads();
    if (g2 == 0) {
        float d1 = 0.f, d2 = 0.f;
        for (int j = 0; j < 64; ++j) { d1 += p.lq1[l * 64 + j] * p.lk1[l * 64 + j]; d2 += p.lq2[l * 64 + j] * p.lk2[l * 64 + j]; }
        const float lam_init = 0.8f - 0.6f * expf(-0.3f * (float)l), lam = expf(d1) - expf(d2) + lam_init;
        float ss = 0.f;
#pragma unroll
        for (int v = 0; v < 4; ++v)
#pragma unroll
            for (int r4 = 0; r4 < 4; ++r4) { const f32x4 o2 = *(const f32x4*)(Ex + ql * 132 + 32 * v + 8 * r4 + 4 * hh);
#pragma unroll
                for (int j = 0; j < 4; ++j) { const float o = O[v][4 * r4 + j] * il - lam * o2[j]; O[v][4 * r4 + j] = o; ss += o * o; } }
        ss += __shfl_xor(ss, 32);
        const float rn = rsqrtf(ss * (1.0f / 128.0f) + 1e-6f) * (1.0f - lam_init);
        if (qrow < LL) { bf16_t* zr = Z + (size_t)(m0 + qrow) * ZS + h * 128;
#pragma unroll
            for (int v = 0; v < 4; ++v)
#pragma unroll
                for (int r4 = 0; r4 < 4; ++r4) { const int vc = 32 * v + 8 * r4 + 4 * hh; const u32x2 gg = *(const u32x2*)(zr + C_AG + vc); const f32x4 nw = *(const f32x4*)(p.att_norm_w + l * 128 + vc);
                    u32x2 ov; ov.x = pk2(O[v][4 * r4] * rn * nw[0] * silu(lo2f(gg.x)), O[v][4 * r4 + 1] * rn * nw[1] * silu(hi2f(gg.x)));
                    ov.y = pk2(O[v][4 * r4 + 2] * rn * nw[2] * silu(lo2f(gg.y)), O[v][4 * r4 + 3] * rn * nw[3] * silu(hi2f(gg.y)));
                    *(u32x2*)(zr + C_AQ + vc) = ov; } }
    }
    __syncthreads();
}

__device__ void post_phase(const Params& p, int l, int g) {
    const int wave = threadIdx.x >> 6, lane = threadIdx.x & 63;
    const float* T = (const float*)(p.ws + WS_T); const float* pw = p.post_w + l * DM;
    for (int m = blockIdx.x * 8 + wave; m < MG; m += gridDim.x * 8) {
        const int b = g * GB + m / LL, t = m % LL;
        if (l == 1 && t < NMETA) continue;
        const float* h = h_in_row(p, l, b, t);
        float* ho = t < NMETA ? (float*)(p.ws + WS_HM) + ((size_t)b * 16 + t) * DM : p.out + ((size_t)b * SEQ + (t - NMETA)) * DM;
        f32x4 v[4]; float ss = 0.f;
#pragma unroll
        for (int i = 0; i < 4; ++i) { v[i] = *(const f32x4*)(T + (size_t)m * DM + (lane + 64 * i) * 4); ss += v[i][0] * v[i][0] + v[i][1] * v[i][1] + v[i][2] * v[i][2] + v[i][3] * v[i][3]; }
        ss = wsum(ss); const float rn = rsqrtf(ss * (1.0f / DM) + 1e-6f);
#pragma unroll
        for (int i = 0; i < 4; ++i) { const f32x4 w = *(const f32x4*)(pw + (lane + 64 * i) * 4); const f32x4 hv = *(const f32x4*)(h + (lane + 64 * i) * 4);
            f32x4 o; o[0] = hv[0] + v[i][0] * rn * w[0]; o[1] = hv[1] + v[i][1] * rn * w[1]; o[2] = hv[2] + v[i][2] * rn * w[2]; o[3] = hv[3] + v[i][3] * rn * w[3];
            *(f32x4*)(ho + (lane + 64 * i) * 4) = o; }
    }
}

constexpr int NPH = 1 + 2 * NG * 7;
template <int s>
__device__ __forceinline__ void run_stage(const Params& p, int l, int g, unsigned char* smem) {
    bf16_t* Z = (bf16_t*)(p.ws + WS_Z);
    if (s == 0) pn_phase(p, l, g);
    else if (s == 1) { const bf16_t* U = (const bf16_t*)(p.ws + WS_U); const bf16_t* W = (const bf16_t*)(p.ws + WS_WIN) + (size_t)l * ZS * 1024; EpiZ epi{Z};
        for (int u = blockIdx.x; u < 33 * 61; u += gridDim.x) gemm_unit(U, 1024, MG, W, 1024, 16, (u % 33) * 256, (u / 33) * 256, smem, epi); }
    else if (s == 2) { rope_phase(p); for (int it = blockIdx.x; it < MG / 8; it += gridDim.x) prep_tile(p, l, it, (float*)smem); }
    else if (s == 3) { for (int it = blockIdx.x; it < 64 + 32 + 544; it += gridDim.x) {
            if (it < 64) rwkv_item(p, l, it, (float*)smem); else if (it < 96) hgrn_item(p, l, it - 64, smem); else attn_item(p, l, it - 96, smem); } }
    else if (s == 4) { const bf16_t* Wl = (const bf16_t*)(p.ws + WS_WOUT + (size_t)l * WOUT_L);
        for (int u = blockIdx.x; u < 3 * 132; u += gridDim.x) { const int br = u / 132, r = u % 132; const int co = br == 0 ? C_AQ : br == 1 ? C_RR : C_HQ; EpiGate epi{Z, (bf16_t*)(p.ws + WS_GATED), br};
            gemm_unit(Z + co, ZS, MG, Wl + (size_t)br * 1024 * 1024, 1024, 16, (r % 33) * 256, (r / 33) * 256, smem, epi); } }
    else if (s == 5) { const bf16_t* Wl = (const bf16_t*)(p.ws + WS_WOUT + (size_t)l * WOUT_L) + 3ull * 1024 * 1024; EpiT epi{(float*)(p.ws + WS_T)};
        for (int u = blockIdx.x; u < 132; u += gridDim.x) gemm_unit((const bf16_t*)(p.ws + WS_GATED), 3072, MG, Wl, 3072, 48, (u % 33) * 256, (u / 33) * 256, smem, epi); }
    else post_phase(p, l, g);
}

template <int s>
__global__ void __launch_bounds__(NTH, 2) stage_k(Params p, int l, int g) {
    extern __shared__ __attribute__((aligned(16))) unsigned char smem[];
    run_stage<s>(p, l, g, smem);
}
__global__ void __launch_bounds__(NTH, 2) p0_k(Params p) {
    extern __shared__ __attribute__((aligned(16))) unsigned char smem[];
    for (int it = blockIdx.x; it < 2 * P0_PER_LAYER; it += gridDim.x) p0_item(p, it, (float*)smem);
}

template <int s> static void launch_stage(const Params& p, int l, int g, int grid, hipStream_t stream) {
    static bool attr = false;
    if (!attr) { (void)hipFuncSetAttribute((const void*)stage_k<s>, hipFuncAttributeMaxDynamicSharedMemorySize, LDS_BYTES); attr = true; }
    hipLaunchKernelGGL(stage_k<s>, dim3(grid), dim3(NTH), LDS_BYTES, stream, p, l, g);
}

extern "C" void kernel_launch(void* const* d_in, const int* in_sizes, int n_in, void* d_out, int out_size, void* d_ws, size_t ws_size, hipStream_t stream) {
    static int grid = 0;
    if (grid == 0) {
        if (ws_size < WS_END) { fprintf(stderr, "kernel_launch: workspace too small: %zu < %zu\n", ws_size, (size_t)WS_END); grid = -1; return; }
        int dev = 0, cus = 0;
        (void)hipGetDevice(&dev); (void)hipDeviceGetAttribute(&cus, hipDeviceAttributeMultiprocessorCount, dev);
        (void)hipFuncSetAttribute((const void*)p0_k, hipFuncAttributeMaxDynamicSharedMemorySize, LDS_BYTES);
        grid = cus > 0 ? cus : 256;
        (void)hipGetLastError();
    }
    if (grid < 0) return;
    Params p{};
    p.x = (const float*)d_in[0]; p.meta = (const float*)d_in[1]; p.pre_w = (const float*)d_in[2]; p.post_w = (const float*)d_in[3]; p.w_in = (const float*)d_in[4];
    p.lq1 = (const float*)d_in[5]; p.lk1 = (const float*)d_in[6]; p.lq2 = (const float*)d_in[7]; p.lk2 = (const float*)d_in[8]; p.att_norm_w = (const float*)d_in[9];
    p.mu = (const float*)d_in[10]; p.w0 = (const float*)d_in[11]; p.w_up = (const float*)d_in[12]; p.a0 = (const float*)d_in[13]; p.a_up = (const float*)d_in[14];
    p.k_k = (const float*)d_in[15]; p.k_a = (const float*)d_in[16]; p.r_k = (const float*)d_in[17]; p.gn_w = (const float*)d_in[18]; p.gn_b = (const float*)d_in[19];
    p.hlb = (const float*)d_in[20]; p.hnw = (const float*)d_in[21]; p.w_att_out = (const float*)d_in[22]; p.w_rwkv_out = (const float*)d_in[23]; p.w_hgrn_out = (const float*)d_in[24]; p.w_o = (const float*)d_in[25];
    p.out = (float*)d_out; p.ws = (unsigned char*)d_ws;
    hipLaunchKernelGGL(p0_k, dim3(grid), dim3(NTH), LDS_BYTES, stream, p);
    for (int l = 0; l < 2; ++l)
        for (int g = 0; g < NG; ++g) {
            launch_stage<0>(p, l, g, grid, stream); launch_stage<1>(p, l, g, grid, stream); launch_stage<2>(p, l, g, grid, stream); launch_stage<3>(p, l, g, grid, stream);
            launch_stage<4>(p, l, g, grid, stream); launch_stage<5>(p, l, g, grid, stream); launch_stage<6>(p, l, g, grid, stream);
        }
}
```

```cpp
#include <hip/hip_runtime.h>
#include <hip/hip_cooperative_groups.h>
#include <cstdio>
namespace cg = cooperative_groups;

typedef unsigned short bf16_t;
typedef short bf16x8 __attribute__((ext_vector_type(8)));
typedef short bf16x4 __attribute__((ext_vector_type(4)));
typedef float f32x4 __attribute__((ext_vector_type(4)));
typedef float f32x16 __attribute__((ext_vector_type(16)));
typedef unsigned u32x2 __attribute__((ext_vector_type(2)));
typedef unsigned u32x4 __attribute__((ext_vector_type(4)));

#ifndef ONE_LAUNCH
#define ONE_LAUNCH 1
#endif

constexpr int DM = 1024, NB = 16, SEQ = 2048, NMETA = 16, LL = 2064, INW = 15488, ZS = 15616;
constexpr int GB = 4, NG = 4, MG = GB * LL;
constexpr int NTH = 512;
constexpr int LDS_MAIN = 159744, LDS_BYTES = LDS_MAIN + 16;
constexpr int C_AQ = 0, C_AK = 1024, C_AV = 2048, C_AG = 3072, C_RR = 4096, C_RK = 5120, C_RV = 6144, C_RG = 7168,
              C_RWD = 8192, C_RAD = 8256, C_HQ = 8320, C_HF = 9344, C_HI = 10368, C_HG = 11392, C_MG = 12416;
constexpr size_t WS_WIN = 0;
constexpr size_t WS_WOUT = WS_WIN + 2ull * ZS * 1024 * 2;
constexpr size_t WOUT_L = 6ull * 1024 * 1024 * 2;
constexpr size_t WS_Z = WS_WOUT + 2 * WOUT_L;
constexpr size_t WS_U = WS_Z + (size_t)MG * ZS * 2;
constexpr size_t WS_P = WS_U + (size_t)MG * 1024 * 2;
constexpr size_t P_ARR = (size_t)MG * 1024 * 2;
constexpr size_t WS_PW = WS_P + 5 * P_ARR;
constexpr size_t WS_PS = WS_PW + (size_t)MG * 1024 * 4;
constexpr size_t WS_HM = WS_PS + (size_t)MG * 16 * 4 * 4;
constexpr size_t WS_LR = WS_HM + 16ull * 16 * 1024 * 4;
constexpr size_t WS_BAR = WS_LR + 4ull * 65536 * 2;
constexpr size_t WS_T = WS_BAR + 16384;
constexpr size_t WS_END = WS_T + (size_t)MG * 1024 * 4;
constexpr size_t WS_GATED = WS_P;
static_assert(WS_GATED + (size_t)MG * 3072 * 2 <= WS_PS, "alias overflow");

struct Params {
    const float* x; const float* meta; const float* pre_w; const float* post_w; const float* w_in;
    const float* lq1; const float* lk1; const float* lq2; const float* lk2; const float* att_norm_w;
    const float* mu; const float* w0; const float* w_up; const float* a0; const float* a_up; const float* k_k; const float* k_a; const float* r_k;
    const float* gn_w; const float* gn_b; const float* hlb; const float* hnw;
    const float* w_att_out; const float* w_rwkv_out; const float* w_hgrn_out; const float* w_o;
    float* out; unsigned char* ws;
};


__device__ __forceinline__ float bf2f(bf16_t h) { return __uint_as_float(((unsigned)h) << 16); }
__device__ __forceinline__ unsigned pk2(float lo, float hi) { unsigned r; asm("v_cvt_pk_bf16_f32 %0, %1, %2" : "=v"(r) : "v"(lo), "v"(hi)); return r; }
__device__ __forceinline__ void mfma_settle(f32x16& x) { asm volatile("s_nop 15\n\ts_nop 3" : "+v"(x)); }
__device__ __forceinline__ bf16_t f2bf(float f) { const __bf16 b = (__bf16)f; return __builtin_bit_cast(unsigned short, b); }
__device__ __forceinline__ float lo2f(unsigned u) { return __uint_as_float(u << 16); }
__device__ __forceinline__ float hi2f(unsigned u) { return __uint_as_float(u & 0xffff0000u); }
__device__ __forceinline__ float sigm(float x) { return __builtin_amdgcn_rcpf(1.0f + __expf(-x)); }
__device__ __forceinline__ float silu(float x) { return x * __builtin_amdgcn_rcpf(1.0f + __expf(-x)); }
__device__ __forceinline__ float tanh_fast(float x) { return 1.0f - 2.0f * __builtin_amdgcn_rcpf(1.0f + __expf(2.0f * x)); }
template <int CTRL> __device__ __forceinline__ float dpp_f(float v) { return __builtin_bit_cast(float, __builtin_amdgcn_update_dpp(0, __builtin_bit_cast(int, v), CTRL, 0xF, 0xF, false)); }
__device__ __forceinline__ float row16_sum(float v) { v += dpp_f<0xB1>(v); v += dpp_f<0x4E>(v); v += dpp_f<0x141>(v); v += dpp_f<0x140>(v); return v; }
template <int M> __device__ __forceinline__ float xor_lane(float v) {
    if (M == 1) return dpp_f<0xB1>(v);
    if (M == 2) return dpp_f<0x4E>(v);
    if (M == 8) return dpp_f<0x128>(v);
    if (M == 4) { const int s = __builtin_bit_cast(int, v); int r = __builtin_amdgcn_update_dpp(0, s, 0x104, 0xF, 0x5, false); r = __builtin_amdgcn_update_dpp(r, s, 0x114, 0xF, 0xA, false); return __builtin_bit_cast(float, r); }
    if (M == 16) {
        const unsigned u = __builtin_bit_cast(unsigned, v);
        const auto sw = __builtin_amdgcn_permlane16_swap(u, u, false, false);
        const bool odd = (__lane_id() & 16) != 0;
        return __builtin_bit_cast(float, odd ? sw[0] : sw[1]); }
    if (M == 32) {
        const unsigned u = __builtin_bit_cast(unsigned, v);
        const auto sw = __builtin_amdgcn_permlane32_swap(u, u, false, false);
        const bool hi = (__lane_id() & 32) != 0;
        return __builtin_bit_cast(float, hi ? sw[0] : sw[1]); }
    return __shfl_xor(v, M);
}
__device__ __forceinline__ float wsum(float v) { v = row16_sum(v); v += xor_lane<16>(v); v += xor_lane<32>(v); return v; }
__device__ __forceinline__ f32x16 mfma32(bf16x8 a, bf16x8 b, f32x16 c) { return __builtin_amdgcn_mfma_f32_32x32x16_bf16(a, b, c, 0, 0, 0); }
__device__ __forceinline__ bf16x8 pack8(const f32x16& x, int s) {
    u32x4 w; w.x = pk2(x[8 * s + 0], x[8 * s + 1]); w.y = pk2(x[8 * s + 2], x[8 * s + 3]); w.z = pk2(x[8 * s + 4], x[8 * s + 5]); w.w = pk2(x[8 * s + 6], x[8 * s + 7]);
    return __builtin_bit_cast(bf16x8, w);
}
__device__ __forceinline__ bf16x8 ld44(const bf16_t* p0, const bf16_t* p1) {
    u32x2 a = *(const u32x2*)p0, b = *(const u32x2*)p1; u32x4 w; w.x = a.x; w.y = a.y; w.z = b.x; w.w = b.y; return __builtin_bit_cast(bf16x8, w);
}

__device__ __forceinline__ int otid() { int t = threadIdx.x; asm volatile("" : "+v"(t)); return t; }
__device__ __forceinline__ int obid() { int b = blockIdx.x; asm volatile("" : "+s"(b)); return b; }
__device__ __forceinline__ const float* h_in_row(const Params& p, int l, int b, int t) {
    if (l == 0) return t < NMETA ? p.meta + (size_t)t * DM : p.x + ((size_t)b * SEQ + (t - NMETA)) * DM;
    return t < NMETA ? (const float*)(p.ws + WS_HM) + ((size_t)b * 16 + t) * DM : p.out + ((size_t)b * SEQ + (t - NMETA)) * DM;
}

constexpr int P0_IN_TILES = 16 * 244, P0_PER_LAYER = P0_IN_TILES + 4 * 256;
__device__ void p0_item(const Params& p, int item, float* lds) {
    int l = item / P0_PER_LAYER; int r = item % P0_PER_LAYER;
    const float* src; bf16_t* dst; int Nsrc, ldd, copies, kt, nt;
    if (item >= 2 * P0_PER_LAYER) { const int x = item - 2 * P0_PER_LAYER; l = x >> 5; const int mtx = (x >> 4) & 1; nt = x & 15; kt = 0; Nsrc = 1024; copies = 1; ldd = 64;
        src = (mtx ? p.a_up : p.w_up) + (size_t)l * 65536; dst = (bf16_t*)(p.ws + WS_LR) + (size_t)(l * 2 + mtx) * 65536; }
    else if (r < P0_IN_TILES) { src = p.w_in + (size_t)l * 1024 * INW; Nsrc = INW; dst = (bf16_t*)(p.ws + WS_WIN) + (size_t)l * ZS * 1024; ldd = 1024; copies = 1; kt = r / 244; nt = r % 244; }
    else { r -= P0_IN_TILES; const int mtx = r >> 8; r &= 255; kt = r >> 4; nt = r & 15; Nsrc = 1024;
        const float* s0 = mtx == 0 ? p.w_att_out : mtx == 1 ? p.w_rwkv_out : mtx == 2 ? p.w_hgrn_out : p.w_o; src = s0 + (size_t)l * 1024 * 1024;
        bf16_t* wl = (bf16_t*)(p.ws + WS_WOUT + (size_t)l * WOUT_L);
        if (mtx < 3) { dst = wl + (size_t)mtx * 1024 * 1024; ldd = 1024; copies = 1; } else { dst = wl + 3ull * 1024 * 1024; ldd = 3072; copies = 3; } }
    const int tid0 = otid();
    for (int idx = tid0; idx < 4096; idx += NTH) { const int kk = idx >> 6, nn = idx & 63, n = nt * 64 + nn;
        lds[nn * 65 + kk] = n < Nsrc ? src[(size_t)(kt * 64 + kk) * Nsrc + n] : 0.f; }
    __syncthreads();
    const bool permw = item < 2 * P0_PER_LAYER;
    for (int idx = tid0; idx < 4096; idx += NTH) { const int nn = idx >> 6, kk = idx & 63; const bf16_t v = f2bf(lds[nn * 65 + kk]);
        const int c5 = nn & 31, nrow = permw ? (nn & 32) + 16 * ((c5 >> 2) & 1) + 4 * (c5 >> 3) + (c5 & 3) : nn;
        for (int c = 0; c < copies; ++c) dst[(size_t)(nt * 64 + nrow) * ldd + c * 1024 + kt * 64 + kk] = v; }
    __syncthreads();
}

__device__ void pn_range(const Params& p, int l, int g, int m0r, int m1r, int mstep) {
    const int tid0 = otid(), wave = tid0 >> 6, lane = tid0 & 63;
    bf16_t* U = (bf16_t*)(p.ws + WS_U); const float* pw = p.pre_w + l * DM;
    for (int m = m0r + wave; m < m1r; m += mstep) {
        const int b = g * GB + m / LL, t = m % LL; const float* h = h_in_row(p, l, b, t);
        f32x4 v[4]; float ss = 0.f;
#pragma unroll
        for (int i = 0; i < 4; ++i) { v[i] = *(const f32x4*)(h + (lane + 64 * i) * 4); ss += v[i][0] * v[i][0] + v[i][1] * v[i][1] + v[i][2] * v[i][2] + v[i][3] * v[i][3]; }
        ss = wsum(ss); const float rn = rsqrtf(ss * (1.0f / DM) + 1e-6f);
#pragma unroll
        for (int i = 0; i < 4; ++i) { const f32x4 w = *(const f32x4*)(pw + (lane + 64 * i) * 4); u32x2 o; o.x = pk2(v[i][0] * rn * w[0], v[i][1] * rn * w[1]); o.y = pk2(v[i][2] * rn * w[2], v[i][3] * rn * w[3]);
            *(u32x2*)(U + (size_t)m * DM + (lane + 64 * i) * 4) = o; }
    }
}

__device__ void pn_phase(const Params& p, int l, int g) { pn_range(p, l, g, obid() * 8, MG, (int)gridDim.x * 8); }

constexpr int BK = 64, HALF = 128, HT = HALF * BK;
__device__ __forceinline__ int lds_byte(int r, int c) { int st = (r >> 4) * 2 + (c >> 5), rr = r & 15, cc = c & 31, ob = rr * 64 + cc * 2; return st * 1024 + (ob ^ (((ob >> 9) & 1) << 5)); }
__device__ __forceinline__ void stage_rc(int b, int& R, int& C) { int st = b / 1024, sb = b % 1024, swz = sb ^ (((sb >> 9) & 1) << 5); R = (st >> 1) * 16 + swz / 64; C = (st & 1) * 32 + (swz % 64) / 2; }

#define LAS __attribute__((address_space(3)))
template <class Epi>
__device__ __forceinline__ void gemm_unit(const bf16_t* A, int lda, int M, const bf16_t* Bt, int ldb, int nt, int brow, int bcol, unsigned char* shm_, const Epi& epi) {
    LAS unsigned char* lds = (LAS unsigned char*)shm_;
    const int tid = otid(), wid = __builtin_amdgcn_readfirstlane(tid >> 6), lane = tid & 63, wr = wid >> 2, wc = wid & 3, fr = lane & 15, fq = lane >> 4;
    unsigned voffA[2], voffB[2];
#pragma unroll
    for (int i = 0; i < 2; ++i) { int R, C; stage_rc(tid * 16 + i * 8192, R, C); voffA[i] = (unsigned)(R * lda + C) * 2u; voffB[i] = (unsigned)(R * ldb + C) * 2u; }
    const size_t kstep = (size_t)(BK * 2), hA = (size_t)HALF * lda * 2, hB = (size_t)HALF * ldb * 2;
    const unsigned ldsw = (unsigned)wid * 1024u;
    const int aoff = lds_byte(wr * 64 + fr, fq * 8), boff = lds_byte(wc * 32 + fr, fq * 8);
    const char* cA = (const char*)(A + (size_t)brow * lda); const char* cB = (const char*)(Bt + (size_t)bcol * ldb);
#define SA(b, h) (((b) * 2 + (h)) * (HT * 2))
#define SB(b, h) ((4 + (b) * 2 + (h)) * (HT * 2))
#define STAGE(bufoff, gbase, voff) do { _Pragma("unroll") for (int _i = 0; _i < 2; ++_i) \
        __builtin_amdgcn_global_load_lds((const unsigned*)((const char*)(gbase) + (voff)[_i]), (LAS unsigned*)(lds + (bufoff) + ldsw + _i * 8192), 16, 0, 0); } while (0)
#define LDA(dst, b, h) do { _Pragma("unroll") for (int m = 0; m < 4; ++m) _Pragma("unroll") for (int k = 0; k < 2; ++k) dst[m][k] = *(const LAS bf16x8*)(lds + SA(b, h) + aoff + m * 2048 + k * 1024); } while (0)
#define LDB(dst, b, h) do { _Pragma("unroll") for (int n = 0; n < 2; ++n) _Pragma("unroll") for (int k = 0; k < 2; ++k) dst[n][k] = *(const LAS bf16x8*)(lds + SB(b, h) + boff + n * 2048 + k * 1024); } while (0)
#define MMA(ai, bj, At_, Bt_) do { __builtin_amdgcn_s_setprio(1); _Pragma("unroll") for (int m = 0; m < 4; ++m) _Pragma("unroll") for (int n = 0; n < 2; ++n) _Pragma("unroll") for (int k = 0; k < 2; ++k) \
      acc[ai][bj][m][n] = __builtin_amdgcn_mfma_f32_16x16x32_bf16(Bt_[n][k], At_[m][k], acc[ai][bj][m][n], 0, 0, 0); \
    __builtin_amdgcn_s_setprio(0); } while (0)
#define WAIT_V(n) asm volatile("s_waitcnt vmcnt(" #n ")" ::: "memory")
#define WAIT_L(n) asm volatile("s_waitcnt lgkmcnt(" #n ")" ::: "memory")
#define BAR __builtin_amdgcn_s_barrier()
#define SCHED __builtin_amdgcn_sched_barrier(0)
    f32x4 acc[2][2][4][2];
#pragma unroll
    for (int a = 0; a < 2; ++a)
#pragma unroll
        for (int b = 0; b < 2; ++b)
#pragma unroll
            for (int m = 0; m < 4; ++m)
#pragma unroll
                for (int n = 0; n < 2; ++n) acc[a][b][m][n] = (f32x4){0.f, 0.f, 0.f, 0.f};
    bf16x8 At[4][2], B0[2][2], B1[2][2];
    STAGE(SB(0, 0), cB, voffB); STAGE(SA(0, 0), cA, voffA); STAGE(SB(0, 1), cB + hB, voffB); STAGE(SA(0, 1), cA + hA, voffA);
    if (wr == 1) BAR;
    WAIT_V(4); BAR;
    STAGE(SB(1, 0), cB + kstep, voffB); STAGE(SA(1, 0), cA + kstep, voffA); STAGE(SB(1, 1), cB + hB + kstep, voffB);
    WAIT_V(6); BAR;
    for (int t = 0; t < nt - 2; t += 2) {
        const char* a1 = cA + (size_t)(t + 1) * kstep; const char* a2 = a1 + kstep; const char* b2 = cB + (size_t)(t + 2) * kstep; const char* a3 = a2 + kstep; const char* b3 = b2 + kstep;
        LDB(B0, 0, 0); SCHED; LDA(At, 0, 0); STAGE(SA(1, 1), a1 + hA, voffA);
        WAIT_L(8); BAR; WAIT_L(0); MMA(0, 0, At, B0); BAR; SCHED;
        LDB(B1, 0, 1); STAGE(SB(0, 0), b2, voffB);
        BAR; WAIT_L(0); MMA(0, 1, At, B1); BAR;
        LDA(At, 0, 1); STAGE(SA(0, 0), a2, voffA);
        BAR; WAIT_L(0); MMA(1, 0, At, B0); BAR; SCHED;
        STAGE(SB(0, 1), b2 + hB, voffB);
        WAIT_V(6); BAR; MMA(1, 1, At, B1); BAR;
        LDB(B0, 1, 0); SCHED; LDA(At, 1, 0); STAGE(SA(0, 1), a2 + hA, voffA);
        WAIT_L(8); BAR; WAIT_L(0); MMA(0, 0, At, B0); BAR; SCHED;
        LDB(B1, 1, 1); STAGE(SB(1, 0), b3, voffB);
        BAR; WAIT_L(0); MMA(0, 1, At, B1); BAR;
        LDA(At, 1, 1); STAGE(SA(1, 0), a3, voffA);
        BAR; WAIT_L(0); MMA(1, 0, At, B0); BAR; SCHED;
        STAGE(SB(1, 1), b3 + hB, voffB);
        WAIT_V(6); BAR; MMA(1, 1, At, B1); BAR;
    }
    { LDB(B0, 0, 0); LDA(At, 0, 0); STAGE(SA(1, 1), cA + (size_t)(nt - 1) * kstep + hA, voffA);
      BAR; WAIT_L(0); MMA(0, 0, At, B0); BAR;
      LDB(B1, 0, 1); BAR; WAIT_L(0); MMA(0, 1, At, B1); BAR;
      LDA(At, 0, 1); WAIT_V(4); BAR; WAIT_L(0); MMA(1, 0, At, B0); MMA(1, 1, At, B1); BAR; }
    { LDB(B0, 1, 0); LDA(At, 1, 0); WAIT_V(2); BAR; WAIT_L(0); MMA(0, 0, At, B0); BAR;
      LDB(B1, 1, 1); WAIT_V(0); BAR; WAIT_L(0); MMA(0, 1, At, B1); BAR;
      LDA(At, 1, 1); BAR; WAIT_L(0); MMA(1, 0, At, B0); MMA(1, 1, At, B1); BAR; }
    if (wr == 0) BAR;
#pragma unroll
    for (int ai = 0; ai < 2; ++ai)
#pragma unroll
        for (int m = 0; m < 4; ++m) { const int row = brow + ai * HALF + wr * 64 + m * 16 + fr;
            if (row < M) {
#pragma unroll
                for (int bj = 0; bj < 2; ++bj) epi(row, bcol + bj * HALF + wc * 32 + fq * 8, acc[ai][bj][m][0], acc[ai][bj][m][1], epi.pre(row, bcol + bj * HALF + wc * 32 + fq * 8)); } }
    __syncthreads();
#undef SA
#undef SB
#undef STAGE
}

struct EpiZ { typedef int Pre; bf16_t* Z; int br;
    __device__ __forceinline__ Pre pre(int, int) const { return 0; }
    __device__ __forceinline__ void operator()(int row, int col, const f32x4& v0, const f32x4& v1, Pre = 0) const { u32x4 o; o.x = pk2(v0[0], v0[1]); o.y = pk2(v0[2], v0[3]); o.z = pk2(v1[0], v1[1]); o.w = pk2(v1[2], v1[3]); *(u32x4*)(Z + (size_t)row * ZS + col) = o; } };
struct EpiGate { typedef u32x4 Pre; const bf16_t* Z; bf16_t* Gd; int br;
    __device__ __forceinline__ Pre pre(int row, int col) const { return *(const u32x4*)(Z + (size_t)row * ZS + C_MG + br * 1024 + col); }
    __device__ __forceinline__ void operator()(int row, int col, const f32x4& v0, const f32x4& v1, Pre g) const { u32x4 o;
        o.x = pk2(v0[0] * sigm(lo2f(g.x)), v0[1] * sigm(hi2f(g.x))); o.y = pk2(v0[2] * sigm(lo2f(g.y)), v0[3] * sigm(hi2f(g.y)));
        o.z = pk2(v1[0] * sigm(lo2f(g.z)), v1[1] * sigm(hi2f(g.z))); o.w = pk2(v1[2] * sigm(lo2f(g.w)), v1[3] * sigm(hi2f(g.w)));
        *(u32x4*)(Gd + (size_t)row * 3072 + br * 1024 + col) = o; } };
struct EpiT { typedef int Pre; float* T; int br;
    __device__ __forceinline__ Pre pre(int, int) const { return 0; }
    __device__ __forceinline__ void operator()(int row, int col, const f32x4& v0, const f32x4& v1, Pre = 0) const { *(f32x4*)(T + (size_t)row * DM + col) = v0; *(f32x4*)(T + (size_t)row * DM + col + 4) = v1; } };

struct UnitDesc { const bf16_t* A; const bf16_t* Bt; int brow, bcol, br; };
template <class Enum, class Epi>
__device__ __forceinline__ void gemm_stream(const Enum& en, Epi epi, int lda, int M, int ldb, int nt, unsigned char* shm_) {
    LAS unsigned char* lds = (LAS unsigned char*)shm_;
    const int tid = otid(), wid = __builtin_amdgcn_readfirstlane(tid >> 6), lane = tid & 63, wr = wid >> 2, wc = wid & 3, fr = lane & 15, fq = lane >> 4;
    UnitDesc cur, nxt; int ui = 0;
    if (!en.get(0, cur)) return;
    unsigned voffA[2], voffB[2];
#pragma unroll
    for (int i = 0; i < 2; ++i) { int R, C; stage_rc(tid * 16 + i * 8192, R, C); voffA[i] = (unsigned)(R * lda + C) * 2u; voffB[i] = (unsigned)(R * ldb + C) * 2u; }
    const size_t kstep = (size_t)(BK * 2), hA = (size_t)HALF * lda * 2, hB = (size_t)HALF * ldb * 2;
    const unsigned ldsw = (unsigned)wid * 1024u;
    const int aoff = lds_byte(wr * 64 + fr, fq * 8), boff = lds_byte(wc * 32 + fr, fq * 8);
#define SA(b, h) (((b) * 2 + (h)) * (HT * 2))
#define SB(b, h) ((4 + (b) * 2 + (h)) * (HT * 2))
#define STAGE(bufoff, gbase, voff) do { _Pragma("unroll") for (int _i = 0; _i < 2; ++_i) \
        __builtin_amdgcn_global_load_lds((const unsigned*)((const char*)(gbase) + (voff)[_i]), (LAS unsigned*)(lds + (bufoff) + ldsw + _i * 8192), 16, 0, 0); } while (0)
    f32x4 acc[2][2][4][2];
#pragma unroll
    for (int a = 0; a < 2; ++a)
#pragma unroll
        for (int b = 0; b < 2; ++b)
#pragma unroll
            for (int m = 0; m < 4; ++m)
#pragma unroll
                for (int n = 0; n < 2; ++n) acc[a][b][m][n] = (f32x4){0.f, 0.f, 0.f, 0.f};
    bf16x8 At[4][2], B0[2][2], B1[2][2];
    const char* cA = (const char*)(cur.A + (size_t)cur.brow * lda); const char* cB = (const char*)(cur.Bt + (size_t)cur.bcol * ldb);
    STAGE(SB(0, 0), cB, voffB); STAGE(SA(0, 0), cA, voffA); STAGE(SB(0, 1), cB + hB, voffB); STAGE(SA(0, 1), cA + hA, voffA);
    if (wr == 1) BAR;
    WAIT_V(4); BAR;
    STAGE(SB(1, 0), cB + kstep, voffB); STAGE(SA(1, 0), cA + kstep, voffA); STAGE(SB(1, 1), cB + hB + kstep, voffB);
    WAIT_V(6); BAR;
    for (;;) {
        const bool has_next = en.get(ui + 1, nxt);
        const char* nA = has_next ? (const char*)(nxt.A + (size_t)nxt.brow * lda) : cA; const char* nB = has_next ? (const char*)(nxt.Bt + (size_t)nxt.bcol * ldb) : cB;
        for (int t = 0; t < nt; t += 2) {
            const bool last = (t == nt - 2);
            const char* a1 = cA + (size_t)(t + 1) * kstep;
            const char* a2 = last ? nA : cA + (size_t)(t + 2) * kstep; const char* b2 = last ? nB : cB + (size_t)(t + 2) * kstep;
            const char* a3 = a2 + kstep; const char* b3 = b2 + kstep;
            LDB(B0, 0, 0); SCHED; LDA(At, 0, 0); STAGE(SA(1, 1), a1 + hA, voffA);
            WAIT_L(8); BAR; WAIT_L(0); MMA(0, 0, At, B0); BAR; SCHED;
            LDB(B1, 0, 1); STAGE(SB(0, 0), b2, voffB);
            BAR; WAIT_L(0); MMA(0, 1, At, B1); BAR;
            LDA(At, 0, 1); STAGE(SA(0, 0), a2, voffA);
            BAR; WAIT_L(0); MMA(1, 0, At, B0); BAR; SCHED;
            STAGE(SB(0, 1), b2 + hB, voffB);
            WAIT_V(6); BAR; MMA(1, 1, At, B1); BAR;
            LDB(B0, 1, 0); SCHED; LDA(At, 1, 0); STAGE(SA(0, 1), a2 + hA, voffA);
            WAIT_L(8); BAR; WAIT_L(0); MMA(0, 0, At, B0); BAR; SCHED;
            LDB(B1, 1, 1); STAGE(SB(1, 0), b3, voffB);
            BAR; WAIT_L(0); MMA(0, 1, At, B1); BAR;
            LDA(At, 1, 1); STAGE(SA(1, 0), a3, voffA);
            BAR; WAIT_L(0); MMA(1, 0, At, B0); BAR; SCHED;
            STAGE(SB(1, 1), b3 + hB, voffB);
            WAIT_V(6); BAR; MMA(1, 1, At, B1); BAR;
        }
        epi.br = cur.br;
        { typename Epi::Pre pre[2][4][2];
#pragma unroll
            for (int ai = 0; ai < 2; ++ai)
#pragma unroll
                for (int m = 0; m < 4; ++m) { const int row = cur.brow + ai * HALF + wr * 64 + m * 16 + fr; const int rc = row < M ? row : M - 1;
#pragma unroll
                    for (int bj = 0; bj < 2; ++bj) pre[ai][m][bj] = epi.pre(rc, cur.bcol + bj * HALF + wc * 32 + fq * 8); }
#pragma unroll
            for (int ai = 0; ai < 2; ++ai)
#pragma unroll
                for (int m = 0; m < 4; ++m) { const int row = cur.brow + ai * HALF + wr * 64 + m * 16 + fr;
                    if (row < M) {
#pragma unroll
                        for (int bj = 0; bj < 2; ++bj) epi(row, cur.bcol + bj * HALF + wc * 32 + fq * 8, acc[ai][bj][m][0], acc[ai][bj][m][1], pre[ai][m][bj]); } } }
        if (!has_next) break;
#pragma unroll
        for (int a = 0; a < 2; ++a)
#pragma unroll
            for (int b = 0; b < 2; ++b)
#pragma unroll
                for (int m = 0; m < 4; ++m)
#pragma unroll
                    for (int n = 0; n < 2; ++n) acc[a][b][m][n] = (f32x4){0.f, 0.f, 0.f, 0.f};
        cur = nxt; cA = nA; cB = nB; ++ui;
    }
    WAIT_V(0);
    if (wr == 0) BAR;
    BAR;
    __syncthreads();
#undef SA
#undef SB
#undef STAGE
}
struct Enum1 { const bf16_t* U; const bf16_t* W; int x, j, nj;
    __device__ __forceinline__ bool get(int i, UnitDesc& u) const { const int v = j + nj * i; int pm, pn;
        if (v < 244) { pn = v >> 2; pm = x + 8 * (v & 3); } else { pn = x + 8 * (v - 244); pm = 32; if (pn >= 61) return false; }
        u.A = U; u.Bt = W; u.brow = pm * 256; u.bcol = pn * 256; u.br = 0; return true; } };
struct Enum1m { const bf16_t* U; const bf16_t* W; int x, j, nj, merged;
    __device__ __forceinline__ bool get(int i, UnitDesc& u) const { int v, pm, pn;
        if (!merged) v = j + nj * i;
        else if (j < 17) { if (i >= 7) return false; v = j + 32 * i; }
        else { if (i < 7) v = j + 32 * i; else if (i < 9) v = 224 + (j - 17) + 15 * (i - 7); else return false; }
        if (v < 244) { pn = v >> 2; pm = x + 8 * (v & 3); } else { pn = x + 8 * (v - 244); pm = 32; if (pn >= 61) return false; }
        u.A = U; u.Bt = W; u.brow = pm * 256; u.bcol = pn * 256; u.br = 0; return true; } };
struct Enum4 { const bf16_t* Z; const bf16_t* Wl; int x, j, nj;
    __device__ __forceinline__ bool get(int i, UnitDesc& u) const { const int v = j + nj * i; int br, pm, pn;
        if (v < 48) { br = v >> 4; pn = (v >> 2) & 3; pm = x + 8 * (v & 3); } else { const int e = x + 8 * (v - 48); if (e >= 12) return false; br = e >> 2; pn = e & 3; pm = 32; }
        u.A = Z + (br == 0 ? C_AQ : br == 1 ? C_RR : C_HQ); u.Bt = Wl + (size_t)br * 1024 * 1024; u.brow = pm * 256; u.bcol = pn * 256; u.br = br; return true; } };
struct Enum5 { const bf16_t* Gt; const bf16_t* Wl; int x, j, nj;
    __device__ __forceinline__ bool get(int i, UnitDesc& u) const { const int v = j + nj * i; int pm, pn;
        if (v < 16) { pn = v >> 2; pm = x + 8 * (v & 3); } else { const int e = x + 8 * (v - 16); if (e >= 4) return false; pn = e; pm = 32; }
        u.A = Gt; u.Bt = Wl; u.brow = pm * 256; u.bcol = pn * 256; u.br = 0; return true; } };

__device__ void rope_phase(const Params& p) {
    const int tid0 = otid(), bid0 = obid(), wave = tid0 >> 6, lane = tid0 & 63, d = lane & 31, qk = lane >> 5;
    bf16_t* Z = (bf16_t*)(p.ws + WS_Z);
    const float inv = 1.0f / powf(10000.0f, (float)(2 * d) / 64.0f);
    for (int m = bid0 * 8 + wave; m < MG; m += gridDim.x * 8) {
        const int t = m % LL; const float ang = (float)t * inv; float sn, cs; sincosf(ang, &sn, &cs);
        const float sc = qk == 0 ? 0.125f : 1.0f;
        bf16_t* base = Z + (size_t)m * ZS + qk * 1024 + d;
        bf16_t r1[16], r2[16];
#pragma unroll
        for (int hh = 0; hh < 16; ++hh) { r1[hh] = base[hh * 64]; r2[hh] = base[hh * 64 + 32]; }
#pragma unroll
        for (int hh = 0; hh < 16; ++hh) { const float x1 = bf2f(r1[hh]), x2 = bf2f(r2[hh]);
            base[hh * 64] = f2bf((x1 * cs - x2 * sn) * sc); base[hh * 64 + 32] = f2bf((x2 * cs + x1 * sn) * sc); }
    }
}

constexpr int NCH = 65;
constexpr int RC_VT = 18 * 1024, RC_SG = RC_VT + 4096, RC_BON = RC_SG + 4096, RC_BYTES = RC_BON + 256;
static_assert((size_t)64 * NCH * RC_BYTES <= WS_HM - WS_P, "chunk records overflow");
constexpr int WLDS = 19968;

__device__ __forceinline__ float half_sum(float v) {
    v = row16_sum(v); v += xor_lane<16>(v); return v;
}

__device__ void rwkv_summary(const Params& p, int l, int item, unsigned char* wl, int lane) {
    const int chain = item / NCH, ci = item % NCH, bl = chain >> 4, h = chain & 15, m0 = bl * LL, c0 = ci * 32, l31 = lane & 31, hh = lane >> 5;
    const bf16_t* Z = (const bf16_t*)(p.ws + WS_Z);
    unsigned char* rec = p.ws + WS_P + (size_t)item * RC_BYTES;
    const float* mu = p.mu + l * 4224;
    f32x16 dlo[2], alo[2];
#pragma unroll
    for (int nt = 0; nt < 2; ++nt)
#pragma unroll
        for (int r = 0; r < 16; ++r) { dlo[nt][r] = 0.f; alo[nt][r] = 0.f; }
    {
        const int t = c0 + l31, tc = t < LL ? t : LL - 1; const bf16_t* zr = Z + (size_t)(m0 + tc) * ZS;
        const bf16_t* WT = (const bf16_t*)(p.ws + WS_LR) + (size_t)(l * 2) * 65536; const bf16_t* AT = WT + 65536;
#pragma unroll
        for (int st = 0; st < 4; ++st) { const int j0 = 8 * hh + 16 * st;
            const u32x4 cw = *(const u32x4*)(zr + C_RWD + j0), ca = *(const u32x4*)(zr + C_RAD + j0);
            u32x4 pw = {0u, 0u, 0u, 0u}, pa = {0u, 0u, 0u, 0u}; if (tc > 0) { pw = *(const u32x4*)(zr - ZS + C_RWD + j0); pa = *(const u32x4*)(zr - ZS + C_RAD + j0); }
            u32x4 fw, fa;
#pragma unroll
            for (int q = 0; q < 4; ++q) { const float m0w = mu[4096 + j0 + 2 * q], m1w = mu[4096 + j0 + 2 * q + 1], m0a = mu[4160 + j0 + 2 * q], m1a = mu[4160 + j0 + 2 * q + 1];
                const float c0w = lo2f(cw[q]), c1w = hi2f(cw[q]), c0a = lo2f(ca[q]), c1a = hi2f(ca[q]);
                fw[q] = pk2(tanh_fast(c0w + (lo2f(pw[q]) - c0w) * m0w), tanh_fast(c1w + (hi2f(pw[q]) - c1w) * m1w));
                fa[q] = pk2(c0a + (lo2f(pa[q]) - c0a) * m0a, c1a + (hi2f(pa[q]) - c1a) * m1a); }
#pragma unroll
            for (int nt = 0; nt < 2; ++nt) { const size_t wo = (size_t)(h * 64 + 32 * nt + l31) * 64 + j0;
                dlo[nt] = mfma32(__builtin_bit_cast(bf16x8, fw), *(const bf16x8*)(WT + wo), dlo[nt]);
                alo[nt] = mfma32(__builtin_bit_cast(bf16x8, fa), *(const bf16x8*)(AT + wo), alo[nt]); }
            __builtin_amdgcn_sched_barrier(0); }
    }
    float KK[2][16], KT[2][16], XR[2][16];
    float gamC[2];
#pragma unroll
    for (int nt = 0; nt < 2; ++nt) {
        const int c = h * 64 + 32 * nt + l31; const int pc = l * 1024 + c;
        const float w0 = p.w0[pc], a0 = p.a0[pc], kkc = p.k_k[pc], kac = p.k_a[pc], mr = mu[c], mk = mu[1024 + c], mv = mu[2048 + c], mgc = mu[3072 + c];
#pragma unroll
        for (int q = 0; q < 4; ++q) { float xv4[4], sg4[4];
#pragma unroll
            for (int e = 0; e < 4; ++e) { const int r = 4 * q + e, tt = 8 * q + 4 * hh + e, t = c0 + tt; const bool valid = t < LL; const int tc = valid ? t : LL - 1;
                const bf16_t* zr = Z + (size_t)(m0 + tc) * ZS + c;
                const float r0 = bf2f(zr[C_RR]), k0 = bf2f(zr[C_RK]), v0 = bf2f(zr[C_RV]), g0 = bf2f(zr[C_RG]);
                float rp = 0.f, kp = 0.f, vp = 0.f, gp = 0.f; if (tc > 0) { rp = bf2f(zr[C_RR - ZS]); kp = bf2f(zr[C_RK - ZS]); vp = bf2f(zr[C_RV - ZS]); gp = bf2f(zr[C_RG - ZS]); }
                float xr = r0 + (rp - r0) * mr, xk = k0 + (kp - k0) * mk, xv = v0 + (vp - v0) * mv; const float xg = g0 + (gp - g0) * mgc;
                const float y = -(w0 + dlo[nt][r]); const float sp = y > 20.f ? y : __logf(1.0f + __expf(y));
                float lw = -__expf(-sp - 0.5f);
                const float al = sigm(a0 + alo[nt][r]);
                if (!valid) { xr = 0.f; xk = 0.f; xv = 0.f; lw = 0.f; }
                dlo[nt][r] = lw; alo[nt][r] = al; XR[nt][r] = xr; KK[nt][r] = xk * kkc; KT[nt][r] = xk * (1.0f + (al - 1.0f) * kac);
                xv4[e] = xv; sg4[e] = silu(xg); }
            u32x2 o; o.x = pk2(xv4[0], xv4[1]); o.y = pk2(xv4[2], xv4[3]); *(u32x2*)(rec + RC_VT + (32 * nt + l31) * 64 + (8 * q + 4 * hh) * 2) = o;
            o.x = pk2(sg4[0], sg4[1]); o.y = pk2(sg4[2], sg4[3]); *(u32x2*)(rec + RC_SG + (32 * nt + l31) * 64 + (8 * q + 4 * hh) * 2) = o;
            if (q & 1) __builtin_amdgcn_sched_barrier(0); }
    }
    {
        const float rk0 = p.r_k[l * 1024 + h * 64 + l31], rk1 = p.r_k[l * 1024 + h * 64 + 32 + l31];
#pragma unroll
        for (int r = 0; r < 16; ++r) { const float ss = half_sum(KK[0][r] * KK[0][r] + KK[1][r] * KK[1][r]); const float inv = rsqrtf(fmaxf(ss, 1e-24f)); KK[0][r] *= inv; KK[1][r] *= inv;
            const float bon = half_sum(XR[0][r] * KT[0][r] * rk0 + XR[1][r] * KT[1][r] * rk1);
            if (l31 == 0) ((bf16_t*)(rec + RC_BON))[(r & 3) + 8 * (r >> 2) + 4 * hh] = f2bf(bon); }
    }
#pragma unroll
    for (int nt = 0; nt < 2; ++nt) { float tot[4], ptot[4];
#pragma unroll
        for (int q = 0; q < 4; ++q) { dlo[nt][4 * q + 1] += dlo[nt][4 * q]; dlo[nt][4 * q + 2] += dlo[nt][4 * q + 1]; dlo[nt][4 * q + 3] += dlo[nt][4 * q + 2]; tot[q] = dlo[nt][4 * q + 3]; }
#pragma unroll
        for (int q = 0; q < 4; ++q) ptot[q] = __shfl_xor(tot[q], 32);
        float off = 0.f;
#pragma unroll
        for (int q = 0; q < 4; ++q) { const float t0 = hh ? ptot[q] : tot[q], t1 = hh ? tot[q] : ptot[q]; const float mine = off + (hh ? t0 : 0.f);
#pragma unroll
            for (int e = 0; e < 4; ++e) dlo[nt][4 * q + e] += mine;
            off += t0 + t1; }
        gamC[nt] = off; }
    bf16_t* Bh = (bf16_t*)wl; bf16_t* Kh = Bh + 32 * 72; bf16_t* Atl = Kh + 32 * 72; bf16_t* Rt = Atl + 32 * 72;
    u32x4* kstash = (u32x4*)(rec + 8 * 1024);
#pragma unroll
    for (int nt = 0; nt < 2; ++nt) { unsigned aw[8], bw[8], kw[8];
#pragma unroll
        for (int q = 0; q < 4; ++q) {
            const float plast = __shfl_xor(dlo[nt][4 * q + 3], 32); const float plastp = q > 0 ? __shfl_xor(dlo[nt][4 * (q > 0 ? q - 1 : 0) + 3], 32) : 0.f;
            float prevc = hh ? plast : plastp; float at[4], bc[4], kc[4];
#pragma unroll
            for (int e = 0; e < 4; ++e) { const int r = 4 * q + e, tt = 8 * q + 4 * hh + e; const float cum = dlo[nt][r];
                const float g = __expf(cum), ig = __expf(-cum), gce = __expf(gamC[nt] - cum), gp = __expf(prevc); prevc = cum;
                const float bb = KK[nt][r] * alo[nt][r];
                at[e] = -KK[nt][r] * gp; bc[e] = bb * gce; kc[e] = KT[nt][r] * gce;
                Bh[tt * 72 + 32 * nt + l31] = f2bf(bb * ig); Kh[tt * 72 + 32 * nt + l31] = f2bf(KT[nt][r] * ig); Rt[tt * 72 + 32 * nt + l31] = f2bf(XR[nt][r] * g); Atl[tt * 72 + 32 * nt + l31] = f2bf(at[e]); }
            aw[2 * q] = pk2(at[0], at[1]); aw[2 * q + 1] = pk2(at[2], at[3]); bw[2 * q] = pk2(bc[0], bc[1]); bw[2 * q + 1] = pk2(bc[2], bc[3]);
            kw[2 * q] = pk2(kc[0], kc[1]); kw[2 * q + 1] = pk2(kc[2], kc[3]);
            __builtin_amdgcn_sched_barrier(0); }
#pragma unroll
        for (int st = 0; st < 2; ++st) { u32x4 wa, wb; wa.x = aw[4 * st]; wa.y = aw[4 * st + 1]; wa.z = aw[4 * st + 2]; wa.w = aw[4 * st + 3]; wb.x = bw[4 * st]; wb.y = bw[4 * st + 1]; wb.z = bw[4 * st + 2]; wb.w = bw[4 * st + 3];
            ((u32x4*)rec)[(nt * 2 + st) * 64 + lane] = wa; ((u32x4*)rec)[(4 + nt * 2 + st) * 64 + lane] = wb;
            u32x4 wk; wk.x = kw[4 * st]; wk.y = kw[4 * st + 1]; wk.z = kw[4 * st + 2]; wk.w = kw[4 * st + 3]; kstash[(nt * 2 + st) * 64 + lane] = wk; }
    }
    const float gC0 = __expf(gamC[0]), gC1 = __expf(gamC[1]);
    asm volatile("s_waitcnt lgkmcnt(0)" ::: "memory");
    f32x16 Nab, Nak, Mbr, Mkr;
#pragma unroll
    for (int r = 0; r < 16; ++r) { Nab[r] = 0.f; Nak[r] = 0.f; Mbr[r] = 0.f; Mkr[r] = 0.f; }
#pragma unroll
    for (int st = 0; st < 4; ++st) { const int o = l31 * 72 + 8 * hh + 16 * st;
        const bf16x8 fb = *(const bf16x8*)(Bh + o), fk = *(const bf16x8*)(Kh + o), fa = *(const bf16x8*)(Atl + o), fr = *(const bf16x8*)(Rt + o);
        Nab = mfma32(fb, fa, Nab); Nak = mfma32(fk, fa, Nak); Mbr = mfma32(fb, fr, Mbr); Mkr = mfma32(fk, fr, Mkr); }
    f32x16 Rp[2];
#pragma unroll
    for (int mt = 0; mt < 2; ++mt)
#pragma unroll
        for (int q = 0; q < 4; ++q) { const u32x2 v = *(const u32x2*)(Rt + l31 * 72 + 32 * mt + 8 * q + 4 * hh);
            Rp[mt][4 * q] = lo2f(v.x); Rp[mt][4 * q + 1] = hi2f(v.x); Rp[mt][4 * q + 2] = lo2f(v.y); Rp[mt][4 * q + 3] = hi2f(v.y); }
#pragma unroll
    for (int r = 0; r < 16; ++r) { const int s = (r & 3) + 8 * (r >> 2) + 4 * hh; if (s >= l31) { Nab[r] = 0.f; Nak[r] = 0.f; } if (s > l31) { Mbr[r] = 0.f; Mkr[r] = 0.f; } }
    asm volatile("s_waitcnt lgkmcnt(0)" ::: "memory");
    float* Nl = (float*)wl; bf16_t* NakL = (bf16_t*)(wl + 4096);
#pragma unroll
    for (int r = 0; r < 16; ++r) { const int s = (r & 3) + 8 * (r >> 2) + 4 * hh; Nl[s * 32 + l31] = Nab[r]; NakL[s * 40 + l31] = f2bf(Nak[r]); }
    asm volatile("s_waitcnt lgkmcnt(0)" ::: "memory");
    float T[32];
#pragma unroll
    for (int s = 31; s >= 0; --s) { float acc = (s == l31) ? 1.0f : 0.0f;
#pragma unroll
        for (int s2 = s + 1; s2 < 32; ++s2) acc += Nl[s * 32 + s2] * T[s2];
        T[s] = acc; if ((s & 3) == 0) __builtin_amdgcn_sched_barrier(0); }
    bf16x8 Tf[2];
#pragma unroll
    for (int st = 0; st < 2; ++st) { u32x4 w;
#pragma unroll
        for (int q = 0; q < 4; ++q) { const int sa = 16 * st + 8 * (q >> 1) + 2 * (q & 1); w[q] = hh ? pk2(T[sa + 4], T[sa + 5]) : pk2(T[sa], T[sa + 1]); }
        Tf[st] = __builtin_bit_cast(bf16x8, w); }
    bf16x8 AtP[2][2], BcP[2][2];
#pragma unroll
    for (int nt = 0; nt < 2; ++nt)
#pragma unroll
        for (int st = 0; st < 2; ++st) { AtP[nt][st] = ((const bf16x8*)rec)[(nt * 2 + st) * 64 + lane]; BcP[nt][st] = ((const bf16x8*)rec)[(4 + nt * 2 + st) * 64 + lane]; }
    f32x16 ApT[2], W1T;
#pragma unroll
    for (int r = 0; r < 16; ++r) { ApT[0][r] = 0.f; ApT[1][r] = 0.f; W1T[r] = 0.f; }
#pragma unroll
    for (int st = 0; st < 2; ++st) { ApT[0] = mfma32(Tf[st], AtP[0][st], ApT[0]); ApT[1] = mfma32(Tf[st], AtP[1][st], ApT[1]);
        const bf16_t* nk = NakL + l31 * 40 + 16 * st + 4 * hh; W1T = mfma32(Tf[st], ld44(nk, nk + 8), W1T); }
    mfma_settle(ApT[0]); mfma_settle(ApT[1]); mfma_settle(W1T);
    bf16x8 ApF[2][2], W1F[2], MbF[2];
#pragma unroll
    for (int st = 0; st < 2; ++st) { ApF[0][st] = pack8(ApT[0], st); ApF[1][st] = pack8(ApT[1], st); W1F[st] = pack8(W1T, st); MbF[st] = pack8(Mbr, st); }
    bf16x8* out = (bf16x8*)rec;
#pragma unroll
    for (int jt = 0; jt < 2; ++jt) {
#pragma unroll
        for (int j2 = 0; j2 < 2; ++j2) { f32x16 G;
#pragma unroll
            for (int r = 0; r < 16; ++r) G[r] = (jt == j2 && ((r & 3) + 8 * (r >> 2) + 4 * hh) == l31) ? (j2 ? gC1 : gC0) : 0.f;
            G = mfma32(ApF[jt][0], BcP[j2][0], G); G = mfma32(ApF[jt][1], BcP[j2][1], G); mfma_settle(G);
            out[((jt * 2 + j2) * 2 + 0) * 64 + lane] = pack8(G, 0); out[((jt * 2 + j2) * 2 + 1) * 64 + lane] = pack8(G, 1); }
        Rp[jt] = mfma32(ApF[jt][0], MbF[0], Rp[jt]); Rp[jt] = mfma32(ApF[jt][1], MbF[1], Rp[jt]); mfma_settle(Rp[jt]);
        out[(12 + jt * 2 + 0) * 64 + lane] = pack8(Rp[jt], 0); out[(12 + jt * 2 + 1) * 64 + lane] = pack8(Rp[jt], 1); }
#pragma unroll
    for (int j2 = 0; j2 < 2; ++j2) { f32x16 H;
#pragma unroll
        for (int st = 0; st < 2; ++st) { const u32x4 wk = kstash[(j2 * 2 + st) * 64 + lane];
#pragma unroll
            for (int q = 0; q < 4; ++q) { H[8 * st + 2 * q] = lo2f(wk[q]); H[8 * st + 2 * q + 1] = hi2f(wk[q]); } }
        H = mfma32(W1F[0], BcP[j2][0], H); H = mfma32(W1F[1], BcP[j2][1], H); mfma_settle(H);
        out[(8 + j2 * 2 + 0) * 64 + lane] = pack8(H, 0); out[(8 + j2 * 2 + 1) * 64 + lane] = pack8(H, 1); }
    Mkr = mfma32(W1F[0], MbF[0], Mkr); Mkr = mfma32(W1F[1], MbF[1], Mkr); mfma_settle(Mkr);
    out[(16 + 0) * 64 + lane] = pack8(Mkr, 0); out[(16 + 1) * 64 + lane] = pack8(Mkr, 1);
    asm volatile("s_waitcnt lgkmcnt(0)" ::: "memory");
}

__device__ void rwkv_seq(const Params& p, int l, int chain, int it, int lane, float* ex, int cl, unsigned char* wstage) {
    LAS unsigned char* wl = (LAS unsigned char*)wstage;
    const int bl = chain >> 4, h = chain & 15, m0 = bl * LL, l31 = lane & 31, hh = lane >> 5;
    bf16_t* Z = (bf16_t*)(p.ws + WS_Z);
    f32x16 ST[2];
#pragma unroll
    for (int a = 0; a < 2; ++a)
#pragma unroll
        for (int r = 0; r < 16; ++r) ST[a][r] = 0.f;
    const float gw0 = p.gn_w[l * 1024 + h * 64 + 32 * it + l31], gb0 = p.gn_b[l * 1024 + h * 64 + 32 * it + l31];
    bf16x8 vb[2], vbn[2];
#define RW_LOAD(ci_) do { const unsigned char* rc_ = p.ws + WS_P + (size_t)(chain * NCH + (ci_)) * RC_BYTES; \
        _Pragma("unroll") for (int f = 0; f < 18; ++f) __builtin_amdgcn_global_load_lds((const unsigned*)(rc_ + f * 1024 + lane * 16), (LAS unsigned*)(wl + f * 1024), 16, 0, 0); \
        _Pragma("unroll") for (int st = 0; st < 2; ++st) { const bf16_t* vp_ = (const bf16_t*)(rc_ + RC_VT) + (32 * it + l31) * 32 + 16 * st + 4 * hh; \
            const u32x2 a_ = *(const u32x2*)vp_, b_ = *(const u32x2*)(vp_ + 8); u32x4 w_; w_.x = a_.x; w_.y = a_.y; w_.z = b_.x; w_.w = b_.y; vbn[st] = __builtin_bit_cast(bf16x8, w_); } } while (0)
    RW_LOAD(0); vb[0] = vbn[0]; vb[1] = vbn[1];
    for (int ci = 0; ci < NCH; ++ci) {
        const unsigned char* rec = p.ws + WS_P + (size_t)(chain * NCH + ci) * RC_BYTES;
        asm volatile("s_waitcnt vmcnt(0)" ::: "memory");
        bf16x8 fr[18];
#pragma unroll
        for (int f = 0; f < 18; ++f) fr[f] = *(const LAS bf16x8*)(wl + f * 1024 + lane * 16);
        bf16x8 sp[2][2];
#pragma unroll
        for (int jt = 0; jt < 2; ++jt) { sp[jt][0] = pack8(ST[jt], 0); sp[jt][1] = pack8(ST[jt], 1); }
        u32x2 ev[4], es[4], bon[4];
#pragma unroll
        for (int q = 0; q < 4; ++q) { ev[q] = *(const u32x2*)(rec + RC_VT + (32 * it + l31) * 64 + (8 * q + 4 * hh) * 2); es[q] = *(const u32x2*)(rec + RC_SG + (32 * it + l31) * 64 + (8 * q + 4 * hh) * 2);
            bon[q] = *(const u32x2*)(rec + RC_BON + (8 * q + 4 * hh) * 2); }
        __builtin_amdgcn_sched_barrier(0);
        asm volatile("s_waitcnt lgkmcnt(0)" ::: "memory");
        if (ci + 1 < NCH) RW_LOAD(ci + 1);
        __builtin_amdgcn_sched_barrier(0);
        f32x16 O;
#pragma unroll
        for (int r = 0; r < 16; ++r) O[r] = 0.f;
#pragma unroll
        for (int jt = 0; jt < 2; ++jt)
#pragma unroll
            for (int st = 0; st < 2; ++st) O = mfma32(fr[12 + jt * 2 + st], sp[jt][st], O);
#pragma unroll
        for (int st = 0; st < 2; ++st) O = mfma32(fr[16 + st], vb[st], O);
#pragma unroll
        for (int j2 = 0; j2 < 2; ++j2) { f32x16 Sn;
#pragma unroll
            for (int r = 0; r < 16; ++r) Sn[r] = 0.f;
#pragma unroll
            for (int jt = 0; jt < 2; ++jt)
#pragma unroll
                for (int st = 0; st < 2; ++st) Sn = mfma32(fr[(jt * 2 + j2) * 2 + st], sp[jt][st], Sn);
#pragma unroll
            for (int st = 0; st < 2; ++st) Sn = mfma32(fr[8 + j2 * 2 + st], vb[st], Sn);
            ST[j2] = Sn; }
        __builtin_amdgcn_sched_barrier(0);
        vb[0] = vbn[0]; vb[1] = vbn[1];
        float* exw = ex + ((ci & 1) * 8 + cl * 2) * 64;
        {
            float a[16], b[16];
#pragma unroll
            for (int r = 0; r < 16; ++r) { a[r] = O[r]; b[r] = O[r] * O[r]; }
#define RW_STEP(n, m) _Pragma("unroll") for (int k = 0; k < (n); ++k) { const bool up = (l31 & (m)) != 0; \
                const float ka = up ? a[k + (n)] : a[k], sa = up ? a[k] : a[k + (n)], kb = up ? b[k + (n)] : b[k], sb = up ? b[k] : b[k + (n)]; \
                a[k] = ka + xor_lane<(m)>(sa); b[k] = kb + xor_lane<(m)>(sb); }
            RW_STEP(8, 16) RW_STEP(4, 8) RW_STEP(2, 4) RW_STEP(1, 2)
#undef RW_STEP
            a[0] += xor_lane<1>(a[0]); b[0] += xor_lane<1>(b[0]);
            if ((l31 & 1) == 0) { const int r = l31 >> 1, tt = (r & 3) + 8 * (r >> 2) + 4 * hh; exw[it * 64 + tt * 2] = a[0]; exw[it * 64 + tt * 2 + 1] = b[0]; }
        }
        asm volatile("s_waitcnt lgkmcnt(0)" ::: "memory"); __builtin_amdgcn_s_barrier(); asm volatile("" ::: "memory");
        bf16_t* Zc = Z + (size_t)(m0 + ci * 32) * ZS + C_RR + h * 64 + 32 * it; const unsigned voff = (unsigned)(4 * hh) * ZS + l31;
#pragma unroll
        for (int q = 0; q < 4; ++q)
#pragma unroll
            for (int e = 0; e < 4; ++e) { const int r = 4 * q + e, tt = 8 * q + 4 * hh + e, t = ci * 32 + tt;
                const float ps1 = exw[tt * 2] + exw[64 + tt * 2], ps2 = exw[tt * 2 + 1] + exw[64 + tt * 2 + 1];
                const float mean = ps1 * (1.0f / 64.0f), var = fmaxf(ps2 * (1.0f / 64.0f) - mean * mean, 0.f);
                const float rs = rsqrtf(var + 64e-5f), d0 = O[r] - mean;
                const unsigned vv0 = e < 2 ? ev[q].x : ev[q].y, ss0 = e < 2 ? es[q].x : es[q].y;
                const float va = (e & 1) ? hi2f(vv0) : lo2f(vv0), sa = (e & 1) ? hi2f(ss0) : lo2f(ss0);
                const float y0 = (d0 * rs * gw0 + gb0 + ((e & 1) ? hi2f(e < 2 ? bon[q].x : bon[q].y) : lo2f(e < 2 ? bon[q].x : bon[q].y)) * va) * sa;
                if (t < LL) Zc[(unsigned)(8 * q + e) * ZS + voff] = f2bf(y0); }
    }
#undef RW_LOAD
}

constexpr size_t WS_HS = WS_P + (size_t)64 * NCH * RC_BYTES;
constexpr int HS_BYTES = 3072;
constexpr size_t WS_HL = WS_HS + (size_t)32 * NCH * HS_BYTES;
static_assert(WS_HL + (size_t)32 * 24576 <= WS_HM, "hgrn side records overflow");

__device__ __forceinline__ bf16_t* hfrag(const Params& p, int bl, int h, int ci, int arr, int f, int lane) {
    if (ci < 64) return (bf16_t*)(p.ws + WS_Z) + (size_t)(bl * LL + ci * 32 + 4 * f + (lane >> 4)) * ZS + (arr == 0 ? C_HQ : arr == 1 ? C_HF : C_HI) + h * 128 + (lane & 15) * 8;
    return (bf16_t*)(p.ws + WS_HL + (size_t)(bl * 8 + h) * 24576 + (arr * 8 + f) * 1024 + lane * 16);
}

__device__ void hgrn_summary(const Params& p, int l, int item, unsigned char* smem) {
    const int chain = item / NCH, ci = item % NCH, bl = chain >> 3, h = chain & 7, m0 = bl * LL, tid = otid(), w = tid >> 6, lane = tid & 63, l31 = lane & 31, hh = lane >> 5;
    float* Gf = (float*)smem; float* Qf = (float*)(smem + 16384); float* Kf = (float*)(smem + 32768); float* dec = (float*)(smem + 49152);
    bf16_t* Qh = (bf16_t*)(smem + 49664); bf16_t* Kc = (bf16_t*)(smem + 58368); bf16_t* KbT = (bf16_t*)(smem + 67072); bf16_t* VT = (bf16_t*)(smem + 77312);
    bf16_t* attL = (bf16_t*)(smem + 87552);
    const bf16_t* Z = (const bf16_t*)(p.ws + WS_Z);
    const int t0 = ci * 32;
    {
        const int tt = tid >> 4, k0 = (tid & 15) * 8, t = t0 + tt; const bool valid = t < LL; const int tc = valid ? t : LL - 1;
        bf16_t* zr = (bf16_t*)(p.ws + WS_Z) + (size_t)(m0 + tc) * ZS + h * 128 + k0;
        const u32x4 wq = *(const u32x4*)(zr + C_HQ), wf = *(const u32x4*)(zr + C_HF), wi = *(const u32x4*)(zr + C_HI), wg = *(const u32x4*)(zr + C_HG);
        f32x4 lb0 = {0.f, 0.f, 0.f, 0.f}, lb1 = {0.f, 0.f, 0.f, 0.f};
        if (l == 1) { const f32x4 a0 = *(const f32x4*)(p.hlb + h * 128 + k0), a1 = *(const f32x4*)(p.hlb + h * 128 + k0 + 4), b0 = *(const f32x4*)(p.hlb + 1024 + h * 128 + k0), b1 = *(const f32x4*)(p.hlb + 1024 + h * 128 + k0 + 4);
#pragma unroll
            for (int j = 0; j < 4; ++j) { lb0[j] = __builtin_amdgcn_rcpf(1.0f + __expf(a0[j] - b0[j])); lb1[j] = __builtin_amdgcn_rcpf(1.0f + __expf(a1[j] - b1[j])); } }
        float g[8], q[8], kk[8], sg[8];
#pragma unroll
        for (int j = 0; j < 8; ++j) { const unsigned uq = wq[j >> 1], uf = wf[j >> 1], ug = wg[j >> 1];
            const float hq = (j & 1) ? hi2f(uq) : lo2f(uq), hf = (j & 1) ? hi2f(uf) : lo2f(uf), hg = (j & 1) ? hi2f(ug) : lo2f(ug), lb = j < 4 ? lb0[j & 3] : lb1[j & 3];
            const float fg = lb + (1.0f - lb) * sigm(hf);
            g[j] = valid ? __logf(fg) : 0.f; q[j] = valid ? silu(hq) : 0.f; kk[j] = valid ? 1.0f - fg : 0.f; sg[j] = silu(hg);
            const unsigned ui = wi[j >> 1]; VT[(k0 + j) * 40 + tt] = valid ? (bf16_t)((j & 1) ? (ui >> 16) : (ui & 0xffffu)) : (bf16_t)0; }
        *(f32x4*)(Gf + tt * 128 + k0) = (f32x4){g[0], g[1], g[2], g[3]}; *(f32x4*)(Gf + tt * 128 + k0 + 4) = (f32x4){g[4], g[5], g[6], g[7]};
        *(f32x4*)(Qf + tt * 128 + k0) = (f32x4){q[0], q[1], q[2], q[3]}; *(f32x4*)(Qf + tt * 128 + k0 + 4) = (f32x4){q[4], q[5], q[6], q[7]};
        *(f32x4*)(Kf + tt * 128 + k0) = (f32x4){kk[0], kk[1], kk[2], kk[3]}; *(f32x4*)(Kf + tt * 128 + k0 + 4) = (f32x4){kk[4], kk[5], kk[6], kk[7]};
        if (valid) { u32x4 og; og.x = pk2(sg[0], sg[1]); og.y = pk2(sg[2], sg[3]); og.z = pk2(sg[4], sg[5]); og.w = pk2(sg[6], sg[7]); *(u32x4*)(zr + C_HG) = og; }
    }
    __syncthreads();
    if (tid < 128) { float run = 0.f;
#pragma unroll
        for (int tt = 0; tt < 32; ++tt) { run += Gf[tt * 128 + tid]; Gf[tt * 128 + tid] = run; } dec[tid] = __expf(run); }
    __syncthreads();
    for (int e = 0; e < 8; ++e) { const int idx = tid + NTH * e, tt = idx >> 7, k = idx & 127; const float lam = Gf[idx], le = Gf[31 * 128 + k], q = Qf[idx], kk = Kf[idx];
        Qh[tt * 136 + k] = f2bf(q * __expf(lam)); Kc[tt * 136 + k] = f2bf(kk * __expf(-lam)); KbT[k * 40 + tt] = f2bf(kk * __expf(le - lam)); }
    __syncthreads();
    unsigned char* side = p.ws + WS_HS + (size_t)item * HS_BYTES;
    {
        const int kt = w >> 1, s = w & 1; const bf16_t* qa = Qh + l31 * 136 + 32 * kt + 16 * s + 4 * hh;
        *(bf16x8*)hfrag(p, bl, h, ci, 0, w, lane) = ld44(qa, qa + 8);
        *(bf16x8*)hfrag(p, bl, h, ci, 1, w, lane) = *(const bf16x8*)(KbT + (32 * kt + l31) * 40 + 16 * s + 8 * hh);
        *(bf16x8*)hfrag(p, bl, h, ci, 2, w, lane) = *(const bf16x8*)(VT + (32 * kt + l31) * 40 + 16 * s + 8 * hh);
        if (tid < 128) ((float*)(side + 2048))[tid] = dec[tid];
    }
    if (w == 0) {
        f32x16 X;
#pragma unroll
        for (int r = 0; r < 16; ++r) X[r] = 0.f;
#pragma unroll
        for (int s8 = 0; s8 < 8; ++s8) X = mfma32(*(const bf16x8*)(Kc + l31 * 136 + 16 * s8 + 8 * hh), *(const bf16x8*)(Qh + l31 * 136 + 16 * s8 + 8 * hh), X);
#pragma unroll
        for (int r = 0; r < 16; ++r) { const int srow = (r & 3) + 8 * (r >> 2) + 4 * hh; attL[l31 * 40 + srow] = f2bf(srow > l31 ? 0.f : X[r]); }
        asm volatile("s_waitcnt lgkmcnt(0)" ::: "memory");
#pragma unroll
        for (int st = 0; st < 2; ++st) ((bf16x8*)side)[st * 64 + lane] = *(const bf16x8*)(attL + l31 * 40 + 16 * st + 8 * hh);
    }
    __syncthreads();
}

__device__ void hgrn_seq(const Params& p, int l, int chain, unsigned char* smem) {
    const int bl = chain >> 3, h = chain & 7, m0 = bl * LL, tid = otid(), w = tid >> 6, lane = tid & 63, l31 = lane & 31, hh = lane >> 5;
    float* Ob = (float*)smem;
    bf16_t* Z = (bf16_t*)(p.ws + WS_Z);
    const int vt = w & 3, kt0 = 2 * (w >> 2);
    f32x16 S[2];
#pragma unroll
    for (int r = 0; r < 16; ++r) { S[0][r] = 0.f; S[1][r] = 0.f; }
    bf16x8 qf[2][2], kf[2][2], vf[2], af[2]; f32x4 dv[2][4];
    const bf16_t* pq[2][2]; const bf16_t* pk[2][2]; const bf16_t* pv[2];
#pragma unroll
    for (int k2 = 0; k2 < 2; ++k2)
#pragma unroll
        for (int s = 0; s < 2; ++s) { pq[k2][s] = hfrag(p, bl, h, 0, 0, (kt0 + k2) * 2 + s, lane); pk[k2][s] = hfrag(p, bl, h, 0, 1, (kt0 + k2) * 2 + s, lane); }
#pragma unroll
    for (int s = 0; s < 2; ++s) pv[s] = hfrag(p, bl, h, 0, 2, vt * 2 + s, lane);
#define HG_LOAD(ci_) do { const unsigned char* sd_ = p.ws + WS_HS + (size_t)(chain * NCH + (ci_)) * HS_BYTES; \
        if ((ci_) < 64) { const size_t co_ = (size_t)(ci_) * 32 * ZS; \
            _Pragma("unroll") for (int k2 = 0; k2 < 2; ++k2) _Pragma("unroll") for (int s = 0; s < 2; ++s) { qf[k2][s] = *(const bf16x8*)(pq[k2][s] + co_); kf[k2][s] = *(const bf16x8*)(pk[k2][s] + co_); } \
            _Pragma("unroll") for (int s = 0; s < 2; ++s) vf[s] = *(const bf16x8*)(pv[s] + co_); \
        } else { \
            _Pragma("unroll") for (int k2 = 0; k2 < 2; ++k2) _Pragma("unroll") for (int s = 0; s < 2; ++s) { qf[k2][s] = *(const bf16x8*)hfrag(p, bl, h, 64, 0, (kt0 + k2) * 2 + s, lane); kf[k2][s] = *(const bf16x8*)hfrag(p, bl, h, 64, 1, (kt0 + k2) * 2 + s, lane); } \
            _Pragma("unroll") for (int s = 0; s < 2; ++s) vf[s] = *(const bf16x8*)hfrag(p, bl, h, 64, 2, vt * 2 + s, lane); } \
        _Pragma("unroll") for (int s = 0; s < 2; ++s) af[s] = ((const bf16x8*)sd_)[s * 64 + lane]; \
        _Pragma("unroll") for (int k2 = 0; k2 < 2; ++k2) _Pragma("unroll") for (int q = 0; q < 4; ++q) dv[k2][q] = *(const f32x4*)((const float*)(sd_ + 2048) + 32 * (kt0 + k2) + 8 * q + 4 * hh); } while (0)
    HG_LOAD(0);
    const f32x4 nw0 = *(const f32x4*)(p.hnw + l * 128 + (tid & 15) * 8), nw1 = *(const f32x4*)(p.hnw + l * 128 + (tid & 15) * 8 + 4);
    for (int ci = 0; ci < NCH; ++ci) {
        const int t0 = ci * 32;
        u32x4 gg = {0u, 0u, 0u, 0u}; { const int tg = t0 + (tid >> 4); if (tg < LL) gg = *(const u32x4*)(Z + (size_t)(m0 + tg) * ZS + h * 128 + (tid & 15) * 8 + C_HG); }
        f32x16 O;
#pragma unroll
        for (int r = 0; r < 16; ++r) O[r] = 0.f;
#pragma unroll
        for (int k2 = 0; k2 < 2; ++k2)
#pragma unroll
            for (int s = 0; s < 2; ++s) O = mfma32(qf[k2][s], pack8(S[k2], s), O);
        if (w < 4) { O = mfma32(af[0], vf[0], O); O = mfma32(af[1], vf[1], O); }
#pragma unroll
        for (int k2 = 0; k2 < 2; ++k2) {
#pragma unroll
            for (int r = 0; r < 16; ++r) S[k2][r] *= dv[k2][r >> 2][r & 3];
#pragma unroll
            for (int st = 0; st < 2; ++st) S[k2] = mfma32(kf[k2][st], vf[st], S[k2]); }
        if (ci + 1 < NCH) HG_LOAD(ci + 1);
        float* Obw = Ob + ((ci & 1) * 2 + (w >> 2)) * (32 * 132);
#pragma unroll
        for (int r = 0; r < 16; ++r) Obw[((r & 3) + 8 * (r >> 2) + 4 * hh) * 132 + 32 * vt + l31] = O[r];
        __syncthreads();
        { const int tt = tid >> 4, v0 = (tid & 15) * 8, t = t0 + tt; const float* oa = Ob + ((ci & 1) * 2) * (32 * 132) + tt * 132 + v0; const float* ob = oa + 32 * 132;
            const f32x4 a0 = *(const f32x4*)oa, a1 = *(const f32x4*)(oa + 4), b0 = *(const f32x4*)ob, b1 = *(const f32x4*)(ob + 4);
            float o[8]; float ss = 0.f;
#pragma unroll
            for (int j = 0; j < 4; ++j) { o[j] = a0[j] + b0[j]; o[4 + j] = a1[j] + b1[j]; }
#pragma unroll
            for (int j = 0; j < 8; ++j) ss += o[j] * o[j];
            ss = row16_sum(ss);
            const float rn = rsqrtf(ss * (1.0f / 128.0f) + 1e-6f);
            if (t < LL) { bf16_t* zr = Z + (size_t)(m0 + t) * ZS + h * 128 + v0;
                u32x4 ov; ov.x = pk2(o[0] * rn * nw0[0] * lo2f(gg.x), o[1] * rn * nw0[1] * hi2f(gg.x)); ov.y = pk2(o[2] * rn * nw0[2] * lo2f(gg.y), o[3] * rn * nw0[3] * hi2f(gg.y));
                ov.z = pk2(o[4] * rn * nw1[0] * lo2f(gg.z), o[5] * rn * nw1[1] * hi2f(gg.z)); ov.w = pk2(o[6] * rn * nw1[2] * lo2f(gg.w), o[7] * rn * nw1[3] * hi2f(gg.w));
                *(u32x4*)(zr + C_HQ) = ov; } }
    }
    __syncthreads();
#undef HG_LOAD
}

#define TR16(o, a) asm volatile( \
    "ds_read_b64_tr_b16 %0, %16 offset:0\n\tds_read_b64_tr_b16 %1, %16 offset:2176\n\tds_read_b64_tr_b16 %2, %16 offset:64\n\tds_read_b64_tr_b16 %3, %16 offset:2240\n\t" \
    "ds_read_b64_tr_b16 %4, %16 offset:128\n\tds_read_b64_tr_b16 %5, %16 offset:2304\n\tds_read_b64_tr_b16 %6, %16 offset:192\n\tds_read_b64_tr_b16 %7, %16 offset:2368\n\t" \
    "ds_read_b64_tr_b16 %8, %16 offset:4352\n\tds_read_b64_tr_b16 %9, %16 offset:6528\n\tds_read_b64_tr_b16 %10, %16 offset:4416\n\tds_read_b64_tr_b16 %11, %16 offset:6592\n\t" \
    "ds_read_b64_tr_b16 %12, %16 offset:4480\n\tds_read_b64_tr_b16 %13, %16 offset:6656\n\tds_read_b64_tr_b16 %14, %16 offset:4544\n\tds_read_b64_tr_b16 %15, %16 offset:6720\n\t" \
    "s_waitcnt lgkmcnt(0)" \
    : "=&v"(o[0]), "=&v"(o[1]), "=&v"(o[2]), "=&v"(o[3]), "=&v"(o[4]), "=&v"(o[5]), "=&v"(o[6]), "=&v"(o[7]), "=&v"(o[8]), "=&v"(o[9]), "=&v"(o[10]), "=&v"(o[11]), "=&v"(o[12]), "=&v"(o[13]), "=&v"(o[14]), "=&v"(o[15]) \
    : "v"(a) : "memory")

__device__ void attn_item(const Params& p, int l, int item, unsigned char* smem) {
    const int qt = 16 - item / 32, bl = (item & 31) >> 3, h = item & 7, q0 = qt * 128, m0 = bl * LL;
    const int tid = otid(), w = tid >> 6, lane = tid & 63, l31 = lane & 31, hh = lane >> 5, g2 = w >> 2, wq = w & 3;
    bf16_t* Ks = (bf16_t*)smem; bf16_t* Vs = (bf16_t*)(smem + 17408); float* Ex = (float*)(smem + 34816);
    bf16_t* Z = (bf16_t*)(p.ws + WS_Z);
    const int qrow = q0 + wq * 32 + l31, qr = qrow < LL ? qrow : LL - 1;
    const unsigned vaddr = (unsigned)(unsigned long long)(LAS unsigned char*)(smem + 17408) + (unsigned)((((4 * hh + ((lane & 15) >> 2)) * 136) + 16 * ((lane >> 4) & 1) + 4 * (lane & 3)) * 2);
    bf16x8 qf[4];
    { const bf16_t* qp = Z + (size_t)(m0 + qr) * ZS + C_AQ + h * 128 + g2 * 64 + 8 * hh;
#pragma unroll
        for (int s = 0; s < 4; ++s) qf[s] = *(const bf16x8*)(qp + 16 * s); }
    f32x16 O[4];
#pragma unroll
    for (int v = 0; v < 4; ++v)
#pragma unroll
        for (int r = 0; r < 16; ++r) O[v][r] = 0.f;
    float mrun = -1e30f, lrun = 0.f;
    int nkt = (q0 + 128 + 63) / 64; if (nkt > (LL + 63) / 64) nkt = (LL + 63) / 64;
    u32x4 kreg[2], vreg[2];
#define AT_ISSUE(kt_) do { _Pragma("unroll") for (int e = 0; e < 2; ++e) { const int idx = tid + NTH * e, key = idx >> 4, c16 = idx & 15; int kr = (kt_) * 64 + key; kr = kr < LL ? kr : LL - 1; \
        const bf16_t* zr = Z + (size_t)(m0 + kr) * ZS + h * 128 + c16 * 8; kreg[e] = *(const u32x4*)(zr + C_AK); vreg[e] = *(const u32x4*)(zr + C_AV); } } while (0)
    AT_ISSUE(0);
    for (int kt = 0; kt < nkt; ++kt) {
        const int k0 = kt * 64;
        __syncthreads();
#pragma unroll
        for (int e = 0; e < 2; ++e) { const int idx = tid + NTH * e, key = idx >> 4, c16 = idx & 15; *(u32x4*)(Ks + key * 136 + c16 * 8) = kreg[e]; *(u32x4*)(Vs + key * 136 + c16 * 8) = vreg[e]; }
        if (kt + 1 < nkt) AT_ISSUE(kt + 1);
        __syncthreads();
        f32x16 X[2];
#pragma unroll
        for (int t2 = 0; t2 < 2; ++t2) {
#pragma unroll
            for (int r = 0; r < 16; ++r) X[t2][r] = 0.f;
#pragma unroll
            for (int s = 0; s < 4; ++s) X[t2] = mfma32(*(const bf16x8*)(Ks + (32 * t2 + l31) * 136 + g2 * 64 + 16 * s + 8 * hh), qf[s], X[t2]); }
        float mx = -1e30f;
#pragma unroll
        for (int t2 = 0; t2 < 2; ++t2)
#pragma unroll
            for (int r = 0; r < 16; ++r) { const int key = k0 + 32 * t2 + (r & 3) + 8 * (r >> 2) + 4 * hh; if (key > qrow) X[t2][r] = -1e30f; mx = fmaxf(mx, X[t2][r]); }
        mx = fmaxf(mx, __shfl_xor(mx, 32));
        const float mnew = fmaxf(mrun, mx), alpha = __expf(mrun - mnew); float sm = 0.f;
#pragma unroll
        for (int t2 = 0; t2 < 2; ++t2)
#pragma unroll
            for (int r = 0; r < 16; ++r) { const float e = __expf(X[t2][r] - mnew); X[t2][r] = e; sm += e; }
        sm += __shfl_xor(sm, 32); lrun = lrun * alpha + sm; mrun = mnew;
#pragma unroll
        for (int v = 0; v < 4; ++v)
#pragma unroll
            for (int r = 0; r < 16; ++r) O[v][r] *= alpha;
#pragma unroll
        for (int t2 = 0; t2 < 2; ++t2) { u32x2 o[16]; const unsigned va = vaddr + t2 * 8704; TR16(o, va);
#pragma unroll
            for (int s = 0; s < 2; ++s) { const bf16x8 pb = pack8(X[t2], s);
#pragma unroll
                for (int v = 0; v < 4; ++v) { u32x4 fw; fw.x = o[(s * 4 + v) * 2].x; fw.y = o[(s * 4 + v) * 2].y; fw.z = o[(s * 4 + v) * 2 + 1].x; fw.w = o[(s * 4 + v) * 2 + 1].y;
                    O[v] = mfma32(__builtin_bit_cast(bf16x8, fw), pb, O[v]); } } }
    }
#undef AT_ISSUE
    const float il = 1.0f / lrun; const int ql = wq * 32 + l31;
    if (g2 == 1) {
#pragma unroll
        for (int v = 0; v < 4; ++v)
#pragma unroll
            for (int r4 = 0; r4 < 4; ++r4) { f32x4 o; o[0] = O[v][4 * r4] * il; o[1] = O[v][4 * r4 + 1] * il; o[2] = O[v][4 * r4 + 2] * il; o[3] = O[v][4 * r4 + 3] * il;
                *(f32x4*)(Ex + ql * 132 + 32 * v + 8 * r4 + 4 * hh) = o; }
    }
    __syncthreads();
    if (g2 == 0) {
        float d1 = 0.f, d2 = 0.f;
        for (int j = 0; j < 64; ++j) { d1 += p.lq1[l * 64 + j] * p.lk1[l * 64 + j]; d2 += p.lq2[l * 64 + j] * p.lk2[l * 64 + j]; }
        const float lam_init = 0.8f - 0.6f * expf(-0.3f * (float)l), lam = expf(d1) - expf(d2) + lam_init;
        float ss = 0.f;
#pragma unroll
        for (int v = 0; v < 4; ++v)
#pragma unroll
            for (int r4 = 0; r4 < 4; ++r4) { const f32x4 o2 = *(const f32x4*)(Ex + ql * 132 + 32 * v + 8 * r4 + 4 * hh);
#pragma unroll
                for (int j = 0; j < 4; ++j) { const float o = O[v][4 * r4 + j] * il - lam * o2[j]; O[v][4 * r4 + j] = o; ss += o * o; } }
        ss += __shfl_xor(ss, 32);
        const float rn = rsqrtf(ss * (1.0f / 128.0f) + 1e-6f) * (1.0f - lam_init);
        if (qrow < LL) { bf16_t* zr = Z + (size_t)(m0 + qrow) * ZS + h * 128;
            u32x2 gg[4][4]; f32x4 nwv[4][4];
#pragma unroll
            for (int v = 0; v < 4; ++v)
#pragma unroll
                for (int r4 = 0; r4 < 4; ++r4) { gg[v][r4] = *(const u32x2*)(zr + C_AG + 32 * v + 8 * r4 + 4 * hh); nwv[v][r4] = *(const f32x4*)(p.att_norm_w + l * 128 + 32 * v + 8 * r4 + 4 * hh); }
#pragma unroll
            for (int v = 0; v < 4; ++v)
#pragma unroll
                for (int r4 = 0; r4 < 4; ++r4) { const int vc = 32 * v + 8 * r4 + 4 * hh; const f32x4 nw = nwv[v][r4]; const u32x2 g = gg[v][r4];
                    u32x2 ov; ov.x = pk2(O[v][4 * r4] * rn * nw[0] * silu(lo2f(g.x)), O[v][4 * r4 + 1] * rn * nw[1] * silu(hi2f(g.x)));
                    ov.y = pk2(O[v][4 * r4 + 2] * rn * nw[2] * silu(lo2f(g.y)), O[v][4 * r4 + 3] * rn * nw[3] * silu(hi2f(g.y)));
                    *(u32x2*)(zr + C_AQ + vc) = ov; } }
    }
    __syncthreads();
}

__device__ void post_range(const Params& p, int l, int g, int m0r, int m1r, int mstep) {
    const int tid0 = otid(), wave = tid0 >> 6, lane = tid0 & 63;
    const float* T = (const float*)(p.ws + WS_T); const float* pw = p.post_w + l * DM;
    for (int m = m0r + wave; m < m1r; m += mstep) {
        const int b = g * GB + m / LL, t = m % LL;
        if (l == 1 && t < NMETA) continue;
        const float* h = h_in_row(p, l, b, t);
        float* ho = t < NMETA ? (float*)(p.ws + WS_HM) + ((size_t)b * 16 + t) * DM : p.out + ((size_t)b * SEQ + (t - NMETA)) * DM;
        f32x4 v[4]; float ss = 0.f;
#pragma unroll
        for (int i = 0; i < 4; ++i) { v[i] = *(const f32x4*)(T + (size_t)m * DM + (lane + 64 * i) * 4); ss += v[i][0] * v[i][0] + v[i][1] * v[i][1] + v[i][2] * v[i][2] + v[i][3] * v[i][3]; }
        ss = wsum(ss); const float rn = rsqrtf(ss * (1.0f / DM) + 1e-6f);
#pragma unroll
        for (int i = 0; i < 4; ++i) { const f32x4 w = *(const f32x4*)(pw + (lane + 64 * i) * 4); const f32x4 hv = *(const f32x4*)(h + (lane + 64 * i) * 4);
            f32x4 o; o[0] = hv[0] + v[i][0] * rn * w[0]; o[1] = hv[1] + v[i][1] * rn * w[1]; o[2] = hv[2] + v[i][2] * rn * w[2]; o[3] = hv[3] + v[i][3] * rn * w[3];
            *(f32x4*)(ho + (lane + 64 * i) * 4) = o; }
    }
}


__device__ void post_phase(const Params& p, int l, int g) { post_range(p, l, g, obid() * 8, MG, (int)gridDim.x * 8); }

#define XB_TMO      128
#define XB_XCNT(j)  (256  + 64 * (j))
#define XB_XSUB(j)  (1280 + 64 * (j))
#define XB_XGEN(j)  (2304 + 64 * (j))
#define XB_TOP      3328
#define XB_TOPGEN   3392
#define XCD_BAR_WORDS 3456
#define XB_SPIN_CAP (1u << 22)
__device__ __forceinline__ unsigned xb_ld(unsigned* p)              { return __hip_atomic_load(p, __ATOMIC_RELAXED, __HIP_MEMORY_SCOPE_AGENT); }
__device__ __forceinline__ unsigned xb_add(unsigned* p, unsigned v) { return __hip_atomic_fetch_add(p, v, __ATOMIC_RELAXED, __HIP_MEMORY_SCOPE_AGENT); }
__device__ __forceinline__ unsigned xb_xcc_id() { return (unsigned)__builtin_amdgcn_s_getreg((3 << 11) | 20) & 0xFu; }
#define XB_SPIN(cond, bar) do { unsigned _sp = 0; while (cond) { __builtin_amdgcn_s_sleep(1); \
    if ((++_sp & 255u) == 0u) { if (xb_ld(&(bar)[XB_TMO])) break; if (_sp > XB_SPIN_CAP) { atomicAdd(&(bar)[XB_TMO], 1u); break; } } } } while (0)
struct XcdBarrier { unsigned* bar; unsigned x; volatile LAS unsigned* st; };
__device__ __forceinline__ XcdBarrier xcd_barrier_post(unsigned* bar, volatile LAS unsigned* st) {
    XcdBarrier b; b.bar = bar; b.x = xb_xcc_id(); b.st = st;
    if (threadIdx.x == 0) (void)xb_add(&bar[XB_XCNT(b.x)], 1u);
    return b;
}
__device__ __forceinline__ void xcd_barrier_complete(unsigned* bar, unsigned x, unsigned& nloc, unsigned& nx) {
    const unsigned G = gridDim.x * gridDim.y * gridDim.z;
    unsigned sum, cnt, mine, sp = 0u;
    for (;;) {
        sum = 0u; cnt = 0u; mine = 0u;
#pragma unroll
        for (unsigned j = 0; j < 16; ++j) { const unsigned c = xb_ld(&bar[XB_XCNT(j)]); sum += c; cnt += (c > 0u) ? 1u : 0u; mine = (j == x) ? c : mine; }
        if (sum == G) break;
        __builtin_amdgcn_s_sleep(1);
        if ((++sp & 255u) == 0u) { if (xb_ld(&bar[XB_TMO])) break; if (sp > XB_SPIN_CAP) { atomicAdd(&bar[XB_TMO], 1u); break; } }
    }
    nloc = mine > 0u ? mine : 1u; nx = cnt > 0u ? cnt : 1u;
}
__device__ __forceinline__ void xcd_barrier(const XcdBarrier& b, unsigned* bar_) {
    asm volatile("s_waitcnt vmcnt(0)" ::: "memory");
    __syncthreads();
    if (threadIdx.x == 0) {
        unsigned* bar = bar_; const unsigned bx = xb_xcc_id();
        __builtin_amdgcn_s_waitcnt(0);
        unsigned nloc = b.st[0], nx = b.st[1];
        if (nloc == 0u) { xcd_barrier_complete(bar, bx, nloc, nx); b.st[0] = nloc; b.st[1] = nx; }
        const unsigned old = xb_add(&bar[XB_XSUB(bx)], 1u);
        const unsigned gen = old / nloc;
        if (old + 1u == (gen + 1u) * nloc) {
            __builtin_amdgcn_fence(__ATOMIC_RELEASE, "agent");
            asm volatile("s_waitcnt vmcnt(0)" ::: "memory");
            const unsigned og = xb_add(&bar[XB_TOP], 1u);
            const unsigned tg = og / nx;
            if (og + 1u == (tg + 1u) * nx) xb_add(&bar[XB_TOPGEN], 1u);
            else XB_SPIN(xb_ld(&bar[XB_TOPGEN]) == tg, bar);
            __builtin_amdgcn_fence(__ATOMIC_ACQUIRE, "agent");
            xb_add(&bar[XB_XGEN(bx)], 1u);
            asm volatile("s_waitcnt vmcnt(0)" ::: "memory");
        } else {
            XB_SPIN(xb_ld(&bar[XB_XGEN(bx)]) == gen, bar);
            __builtin_amdgcn_fence(__ATOMIC_ACQUIRE, "agent");
            asm volatile("s_waitcnt vmcnt(0)" ::: "memory");
        }
    }
    __syncthreads();
}

constexpr int NPH = 1 + 2 * NG * 7;
template <int s>
__device__ __forceinline__ void run_stage(const Params& p, int l, int g, unsigned char* smem) {
    bf16_t* Z = (bf16_t*)(p.ws + WS_Z);
    if (s == 0) pn_phase(p, l, g);
    else if (s == 1) { const bf16_t* U = (const bf16_t*)(p.ws + WS_U); const bf16_t* W = (const bf16_t*)(p.ws + WS_WIN) + (size_t)l * ZS * 1024; EpiZ epi{Z, 0};
        if ((gridDim.x & 7) == 0) {
            const int b = obid(), x = b & 7, j = b >> 3;
            const Enum1 en{U, W, x, j, (int)(gridDim.x >> 3)}; gemm_stream(en, epi, 1024, MG, 1024, 16, smem);
        } else for (int u = obid(); u < 33 * 61; u += gridDim.x) gemm_unit(U, 1024, MG, W, 1024, 16, (u % 33) * 256, (u / 33) * 256, smem, epi); }
    else if (s == 2) { rope_phase(p);
        unsigned* ctr = (unsigned*)(p.ws + WS_BAR) + 3520 + 64 * (l * NG + g) + 32;
        volatile LAS unsigned* nxt = (volatile LAS unsigned*)(LAS unsigned char*)(smem + LDS_MAIN + 8);
        for (;;) {
            __syncthreads();
            if (threadIdx.x == 0) *nxt = __hip_atomic_fetch_add(ctr, 1u, __ATOMIC_RELAXED, __HIP_MEMORY_SCOPE_AGENT);
            __syncthreads();
            const int it = (int)*nxt;
            if (it >= 64 * NCH / 8 + 32 * NCH) break;
            if (it < 64 * NCH / 8) { const int tid = otid(), wv = tid >> 6; rwkv_summary(p, l, it * 8 + wv, smem + wv * WLDS, tid & 63); }
            else hgrn_summary(p, l, it - 64 * NCH / 8, smem); } }
    else if (s == 3) {
        unsigned* ctr = (unsigned*)(p.ws + WS_BAR) + 3520 + 64 * (l * NG + g);
        const int lgn = l * NG + g + 1, npn = lgn < 2 * NG ? MG / 32 : 0;
        const int lgp = l * NG + g - 1, npo = lgp >= 0 ? MG / 32 : 0;
        volatile LAS unsigned* nxt = (volatile LAS unsigned*)(LAS unsigned char*)(smem + LDS_MAIN + 8);
        for (;;) {
            __syncthreads();
            if (threadIdx.x == 0) *nxt = __hip_atomic_fetch_add(ctr, 1u, __ATOMIC_RELAXED, __HIP_MEMORY_SCOPE_AGENT);
            __syncthreads();
            const int it = (int)*nxt;
            if (it >= 32 + 32 + 544 + npn + npo) break;
            if (it >= 32 + 32 + 544 + npn) { const int k = it - (32 + 32 + 544 + npn); post_range(p, lgp / NG, lgp % NG, 32 * k, 32 * k + 32, 8); continue; }
            if (it >= 32 + 32 + 544) { const int k = it - (32 + 32 + 544); pn_range(p, lgn / NG, lgn % NG, 32 * k, 32 * k + 32, 8); continue; }
            if (it < 32) { const int tid = otid(), wv = tid >> 6;
                if (wv < 4) rwkv_seq(p, l, it * 2 + (wv >> 1), wv & 1, tid & 63, (float*)smem, wv >> 1, smem + 4096 + wv * 19456);
                else { for (int ci = 0; ci < NCH; ++ci) __builtin_amdgcn_s_barrier(); }
                __syncthreads(); }
            else if (it < 64) hgrn_seq(p, l, it - 32, smem); else attn_item(p, l, it - 64, smem); } }
    else if (s == 4) { const bf16_t* Wl = (const bf16_t*)(p.ws + WS_WOUT + (size_t)l * WOUT_L);
        if ((gridDim.x & 7) == 0) { const int b = obid(), x = b & 7, j = b >> 3;
            const Enum4 en{Z, Wl, x, j, (int)(gridDim.x >> 3)}; EpiGate epi{Z, (bf16_t*)(p.ws + WS_GATED), 0}; gemm_stream(en, epi, ZS, MG, 1024, 16, smem);
        } else for (int u = obid(); u < 3 * 132; u += gridDim.x) { const int br = u / 132, r = u % 132; const int co = br == 0 ? C_AQ : br == 1 ? C_RR : C_HQ; EpiGate epi{Z, (bf16_t*)(p.ws + WS_GATED), br};
            gemm_unit(Z + co, ZS, MG, Wl + (size_t)br * 1024 * 1024, 1024, 16, (r % 33) * 256, (r / 33) * 256, smem, epi); } }
    else if (s == 5) { const bf16_t* Wl = (const bf16_t*)(p.ws + WS_WOUT + (size_t)l * WOUT_L) + 3ull * 1024 * 1024; EpiT epi{(float*)(p.ws + WS_T), 0};
        if ((gridDim.x & 7) == 0) { const int b = obid(), x = b & 7, j = b >> 3;
            const Enum5 en{(const bf16_t*)(p.ws + WS_GATED), Wl, x, j, (int)(gridDim.x >> 3)}; gemm_stream(en, epi, 3072, MG, 3072, 48, smem);
        } else for (int u = obid(); u < 132; u += gridDim.x) gemm_unit((const bf16_t*)(p.ws + WS_GATED), 3072, MG, Wl, 3072, 48, (u % 33) * 256, (u / 33) * 256, smem, epi); }
    else post_phase(p, l, g);
}

__device__ __forceinline__ void interval_a(const Params& p, int lg, unsigned char* smem) {
    const int b = obid(), x = b & 7, j = b >> 3, nj = (int)(gridDim.x >> 3);
    if (lg > 0) { const int lp = (lg - 1) / NG; const bf16_t* Wl = (const bf16_t*)(p.ws + WS_WOUT + (size_t)lp * WOUT_L) + 3ull * 1024 * 1024; EpiT epi{(float*)(p.ws + WS_T), 0};
        const Enum5 en{(const bf16_t*)(p.ws + WS_GATED), Wl, x, j, nj}; gemm_stream(en, epi, 3072, MG, 3072, 48, smem); }
    if (lg < 2 * NG) { const int l = lg / NG; const bf16_t* U = (const bf16_t*)(p.ws + WS_U); const bf16_t* W = (const bf16_t*)(p.ws + WS_WIN) + (size_t)l * ZS * 1024; EpiZ epi{(bf16_t*)(p.ws + WS_Z), 0};
        const Enum1m en{U, W, x, j, nj, (lg > 0 && gridDim.x == 256) ? 1 : 0}; gemm_stream(en, epi, 1024, MG, 1024, 16, smem); }
}

template <int s>
__global__ void __launch_bounds__(NTH, 2) stage_k(Params p, int l, int g) {
    extern __shared__ __attribute__((aligned(16))) unsigned char smem[];
    run_stage<s>(p, l, g, smem);
}
__global__ void __launch_bounds__(NTH, 2) p0_k(Params p) {
    extern __shared__ __attribute__((aligned(16))) unsigned char smem[];
    for (int it = obid(); it < 2 * P0_PER_LAYER + 64; it += gridDim.x) p0_item(p, it, (float*)smem);
}


#if ONE_LAUNCH
__global__ void __launch_bounds__(NTH, 2) mega(Params p) {
    extern __shared__ __attribute__((aligned(16))) unsigned char smem[];
    cg::grid_group grid = cg::this_grid();
    volatile LAS unsigned* st = (volatile LAS unsigned*)(LAS unsigned char*)(smem + LDS_MAIN);
    if (threadIdx.x == 0) { st[0] = 0u; st[1] = 0u; }
    __syncthreads();
    const XcdBarrier xb = xcd_barrier_post((unsigned*)(p.ws + WS_BAR), st);
    for (int it = blockIdx.x; it < 2 * P0_PER_LAYER + 64; it += gridDim.x) { if (gridDim.x == 256 && ((it >= P0_PER_LAYER && it < 2 * P0_PER_LAYER) || it >= 2 * P0_PER_LAYER + 32)) continue; p0_item(p, it, (float*)smem); }
    grid.sync();
    { Params q = p; asm volatile("" : "+s"(q.ws)); run_stage<0>(q, 0, 0, smem); xcd_barrier(xb, (unsigned*)(q.ws + WS_BAR)); }
    for (int lg = 0; lg < 2 * NG; ++lg) {
        const int l = lg / NG, g = lg % NG;
        Params q = p; asm volatile("" : "+s"(q.ws));
        interval_a(q, lg, smem); xcd_barrier(xb, (unsigned*)(q.ws + WS_BAR));
        run_stage<2>(q, l, g, smem); xcd_barrier(xb, (unsigned*)(q.ws + WS_BAR));
        run_stage<3>(q, l, g, smem); xcd_barrier(xb, (unsigned*)(q.ws + WS_BAR));
        run_stage<4>(q, l, g, smem);
        if (gridDim.x == 256 && lg < NG) { const int b = blockIdx.x, j = b >> 3, x = b & 7;
            if (j >= 18) for (int k = (j - 18) * 8 + x; k < 1240; k += 112) { const int idx = lg * 1240 + k; p0_item(p, idx < P0_PER_LAYER ? P0_PER_LAYER + idx : 2 * P0_PER_LAYER + 32 + (idx - P0_PER_LAYER), (float*)smem); } }
        xcd_barrier(xb, (unsigned*)(q.ws + WS_BAR));
    }
    { Params q = p; asm volatile("" : "+s"(q.ws)); interval_a(q, 2 * NG, smem); xcd_barrier(xb, (unsigned*)(q.ws + WS_BAR)); run_stage<6>(q, 1, NG - 1, smem); }
}
#endif

template <int s> static void launch_stage(const Params& p, int l, int g, int grid, hipStream_t stream) {
    static bool attr = false;
    if (!attr) { (void)hipFuncSetAttribute((const void*)stage_k<s>, hipFuncAttributeMaxDynamicSharedMemorySize, LDS_BYTES); attr = true; }
    hipLaunchKernelGGL(stage_k<s>, dim3(grid), dim3(NTH), LDS_BYTES, stream, p, l, g);
}

extern "C" void kernel_launch(void* const* d_in, const int* in_sizes, int n_in, void* d_out, int out_size, void* d_ws, size_t ws_size, hipStream_t stream) {
    static int grid = 0;
    if (grid == 0) {
        if (ws_size < WS_END) { fprintf(stderr, "kernel_launch: workspace too small: %zu < %zu\n", ws_size, (size_t)WS_END); grid = -1; return; }
        int dev = 0, cus = 0;
        (void)hipGetDevice(&dev); (void)hipDeviceGetAttribute(&cus, hipDeviceAttributeMultiprocessorCount, dev);
        (void)hipFuncSetAttribute((const void*)p0_k, hipFuncAttributeMaxDynamicSharedMemorySize, LDS_BYTES);
        grid = cus > 0 ? cus : 256;
        (void)hipGetLastError();
    }
    if (grid < 0) return;
    Params p{};
    p.x = (const float*)d_in[0]; p.meta = (const float*)d_in[1]; p.pre_w = (const float*)d_in[2]; p.post_w = (const float*)d_in[3]; p.w_in = (const float*)d_in[4];
    p.lq1 = (const float*)d_in[5]; p.lk1 = (const float*)d_in[6]; p.lq2 = (const float*)d_in[7]; p.lk2 = (const float*)d_in[8]; p.att_norm_w = (const float*)d_in[9];
    p.mu = (const float*)d_in[10]; p.w0 = (const float*)d_in[11]; p.w_up = (const float*)d_in[12]; p.a0 = (const float*)d_in[13]; p.a_up = (const float*)d_in[14];
    p.k_k = (const float*)d_in[15]; p.k_a = (const float*)d_in[16]; p.r_k = (const float*)d_in[17]; p.gn_w = (const float*)d_in[18]; p.gn_b = (const float*)d_in[19];
    p.hlb = (const float*)d_in[20]; p.hnw = (const float*)d_in[21]; p.w_att_out = (const float*)d_in[22]; p.w_rwkv_out = (const float*)d_in[23]; p.w_hgrn_out = (const float*)d_in[24]; p.w_o = (const float*)d_in[25];
    p.out = (float*)d_out; p.ws = (unsigned char*)d_ws;
#if ONE_LAUNCH
    { static bool attr = false; if (!attr) { (void)hipFuncSetAttribute((const void*)mega, hipFuncAttributeMaxDynamicSharedMemorySize, LDS_BYTES); attr = true; }
      (void)hipMemsetAsync((unsigned char*)d_ws + WS_BAR, 0, 16384, stream);
      void* args[] = {&p};
      hipError_t e = hipLaunchCooperativeKernel((const void*)mega, dim3(grid), dim3(NTH), args, LDS_BYTES, stream);
      if (e != hipSuccess) fprintf(stderr, "cooperative launch failed: %s (grid %d)\n", hipGetErrorString(e), grid); }
#else
    hipLaunchKernelGGL(p0_k, dim3(grid), dim3(NTH), LDS_BYTES, stream, p);
    for (int l = 0; l < 2; ++l)
        for (int g = 0; g < NG; ++g) {
            launch_stage<0>(p, l, g, grid, stream); launch_stage<1>(p, l, g, grid, stream); launch_stage<2>(p, l, g, grid, stream); launch_stage<3>(p, l, g, grid, stream);
            launch_stage<4>(p, l, g, grid, stream); launch_stage<5>(p, l, g, grid, stream); launch_stage<6>(p, l, g, grid, stream);
        }
#endif
}
```

```cpp
#include <hip/hip_runtime.h>
#include <hip/hip_cooperative_groups.h>
#include <cstdio>
namespace cg = cooperative_groups;

typedef unsigned short bf16_t;
typedef short bf16x8 __attribute__((ext_vector_type(8)));
typedef short bf16x4 __attribute__((ext_vector_type(4)));
typedef float f32x4 __attribute__((ext_vector_type(4)));
typedef float f32x16 __attribute__((ext_vector_type(16)));
typedef unsigned u32x2 __attribute__((ext_vector_type(2)));
typedef unsigned u32x4 __attribute__((ext_vector_type(4)));

#ifndef ONE_LAUNCH
#define ONE_LAUNCH 1
#endif

constexpr int DM = 1024, NB = 16, SEQ = 2048, NMETA = 16, LL = 2064, INW = 15488, ZS = 15616;
constexpr int GB = 4, NG = 4, MG = GB * LL;
constexpr int NTH = 512;
constexpr int LDS_MAIN = 159744, LDS_BYTES = LDS_MAIN + 16;
constexpr int C_AQ = 0, C_AK = 1024, C_AV = 2048, C_AG = 3072, C_RR = 4096, C_RK = 5120, C_RV = 6144, C_RG = 7168,
              C_RWD = 8192, C_RAD = 8256, C_HQ = 8320, C_HF = 9344, C_HI = 10368, C_HG = 11392, C_MG = 12416;
constexpr size_t WS_WIN = 0;
constexpr size_t WS_WOUT = WS_WIN + 2ull * ZS * 1024 * 2;
constexpr size_t WOUT_L = 6ull * 1024 * 1024 * 2;
constexpr size_t WS_Z = WS_WOUT + 2 * WOUT_L;
constexpr size_t WS_U = WS_Z + (size_t)MG * ZS * 2;
constexpr size_t WS_P = WS_U + (size_t)MG * 1024 * 2;
constexpr size_t P_ARR = (size_t)MG * 1024 * 2;
constexpr size_t WS_PW = WS_P + 5 * P_ARR;
constexpr size_t WS_PS = WS_PW + (size_t)MG * 1024 * 4;
constexpr size_t WS_HM = WS_PS + (size_t)MG * 16 * 4 * 4;
constexpr size_t WS_LR = WS_HM + 16ull * 16 * 1024 * 4;
constexpr size_t WS_BAR = WS_LR + 4ull * 65536 * 2;
constexpr size_t WS_T = WS_BAR + 16384;
constexpr size_t WS_END = WS_T + (size_t)MG * 1024 * 4;
constexpr size_t WS_GATED = WS_P;
static_assert(WS_GATED + (size_t)MG * 3072 * 2 <= WS_PS, "alias overflow");

struct Params {
    const float* x; const float* meta; const float* pre_w; const float* post_w; const float* w_in;
    const float* lq1; const float* lk1; const float* lq2; const float* lk2; const float* att_norm_w;
    const float* mu; const float* w0; const float* w_up; const float* a0; const float* a_up; const float* k_k; const float* k_a; const float* r_k;
    const float* gn_w; const float* gn_b; const float* hlb; const float* hnw;
    const float* w_att_out; const float* w_rwkv_out; const float* w_hgrn_out; const float* w_o;
    float* out; unsigned char* ws;
};


__device__ __forceinline__ float bf2f(bf16_t h) { return __uint_as_float(((unsigned)h) << 16); }
__device__ __forceinline__ unsigned pk2(float lo, float hi) { unsigned r; asm("v_cvt_pk_bf16_f32 %0, %1, %2" : "=v"(r) : "v"(lo), "v"(hi)); return r; }
__device__ __forceinline__ void mfma_settle(f32x16& x) { asm volatile("s_nop 15\n\ts_nop 3" : "+v"(x)); }
__device__ __forceinline__ bf16_t f2bf(float f) { const __bf16 b = (__bf16)f; return __builtin_bit_cast(unsigned short, b); }
__device__ __forceinline__ float lo2f(unsigned u) { return __uint_as_float(u << 16); }
__device__ __forceinline__ float hi2f(unsigned u) { return __uint_as_float(u & 0xffff0000u); }
__device__ __forceinline__ float sigm(float x) { return __builtin_amdgcn_rcpf(1.0f + __expf(-x)); }
__device__ __forceinline__ float silu(float x) { return x * __builtin_amdgcn_rcpf(1.0f + __expf(-x)); }
__device__ __forceinline__ float tanh_fast(float x) { return 1.0f - 2.0f * __builtin_amdgcn_rcpf(1.0f + __expf(2.0f * x)); }
template <int CTRL> __device__ __forceinline__ float dpp_f(float v) { return __builtin_bit_cast(float, __builtin_amdgcn_update_dpp(0, __builtin_bit_cast(int, v), CTRL, 0xF, 0xF, false)); }
__device__ __forceinline__ float row16_sum(float v) { v += dpp_f<0xB1>(v); v += dpp_f<0x4E>(v); v += dpp_f<0x141>(v); v += dpp_f<0x140>(v); return v; }
template <int M> __device__ __forceinline__ float xor_lane(float v) {
    if (M == 1) return dpp_f<0xB1>(v);
    if (M == 2) return dpp_f<0x4E>(v);
    if (M == 8) return dpp_f<0x128>(v);
    if (M == 4) { const int s = __builtin_bit_cast(int, v); int r = __builtin_amdgcn_update_dpp(0, s, 0x104, 0xF, 0x5, false); r = __builtin_amdgcn_update_dpp(r, s, 0x114, 0xF, 0xA, false); return __builtin_bit_cast(float, r); }
    if (M == 16) {
        const unsigned u = __builtin_bit_cast(unsigned, v);
        const auto sw = __builtin_amdgcn_permlane16_swap(u, u, false, false);
        const bool odd = (__lane_id() & 16) != 0;
        return __builtin_bit_cast(float, odd ? sw[0] : sw[1]); }
    return __shfl_xor(v, M);
}
__device__ __forceinline__ float wsum(float v) {
#pragma unroll
    for (int o = 1; o < 64; o <<= 1) v += __shfl_xor(v, o);
    return v;
}
__device__ __forceinline__ f32x16 mfma32(bf16x8 a, bf16x8 b, f32x16 c) { return __builtin_amdgcn_mfma_f32_32x32x16_bf16(a, b, c, 0, 0, 0); }
__device__ __forceinline__ bf16x8 pack8(const f32x16& x, int s) {
    u32x4 w; w.x = pk2(x[8 * s + 0], x[8 * s + 1]); w.y = pk2(x[8 * s + 2], x[8 * s + 3]); w.z = pk2(x[8 * s + 4], x[8 * s + 5]); w.w = pk2(x[8 * s + 6], x[8 * s + 7]);
    return __builtin_bit_cast(bf16x8, w);
}
__device__ __forceinline__ bf16x8 ld44(const bf16_t* p0, const bf16_t* p1) {
    u32x2 a = *(const u32x2*)p0, b = *(const u32x2*)p1; u32x4 w; w.x = a.x; w.y = a.y; w.z = b.x; w.w = b.y; return __builtin_bit_cast(bf16x8, w);
}

__device__ __forceinline__ int otid() { int t = threadIdx.x; asm volatile("" : "+v"(t)); return t; }
__device__ __forceinline__ int obid() { int b = blockIdx.x; asm volatile("" : "+s"(b)); return b; }
__device__ __forceinline__ const float* h_in_row(const Params& p, int l, int b, int t) {
    if (l == 0) return t < NMETA ? p.meta + (size_t)t * DM : p.x + ((size_t)b * SEQ + (t - NMETA)) * DM;
    return t < NMETA ? (const float*)(p.ws + WS_HM) + ((size_t)b * 16 + t) * DM : p.out + ((size_t)b * SEQ + (t - NMETA)) * DM;
}

constexpr int P0_IN_TILES = 16 * 244, P0_PER_LAYER = P0_IN_TILES + 4 * 256;
__device__ void p0_item(const Params& p, int item, float* lds) {
    int l = item / P0_PER_LAYER; int r = item % P0_PER_LAYER;
    const float* src; bf16_t* dst; int Nsrc, ldd, copies, kt, nt;
    if (item >= 2 * P0_PER_LAYER) { const int x = item - 2 * P0_PER_LAYER; l = x >> 5; const int mtx = (x >> 4) & 1; nt = x & 15; kt = 0; Nsrc = 1024; copies = 1; ldd = 64;
        src = (mtx ? p.a_up : p.w_up) + (size_t)l * 65536; dst = (bf16_t*)(p.ws + WS_LR) + (size_t)(l * 2 + mtx) * 65536; }
    else if (r < P0_IN_TILES) { src = p.w_in + (size_t)l * 1024 * INW; Nsrc = INW; dst = (bf16_t*)(p.ws + WS_WIN) + (size_t)l * ZS * 1024; ldd = 1024; copies = 1; kt = r / 244; nt = r % 244; }
    else { r -= P0_IN_TILES; const int mtx = r >> 8; r &= 255; kt = r >> 4; nt = r & 15; Nsrc = 1024;
        const float* s0 = mtx == 0 ? p.w_att_out : mtx == 1 ? p.w_rwkv_out : mtx == 2 ? p.w_hgrn_out : p.w_o; src = s0 + (size_t)l * 1024 * 1024;
        bf16_t* wl = (bf16_t*)(p.ws + WS_WOUT + (size_t)l * WOUT_L);
        if (mtx < 3) { dst = wl + (size_t)mtx * 1024 * 1024; ldd = 1024; copies = 1; } else { dst = wl + 3ull * 1024 * 1024; ldd = 3072; copies = 3; } }
    const int tid0 = otid();
    for (int idx = tid0; idx < 4096; idx += NTH) { const int kk = idx >> 6, nn = idx & 63, n = nt * 64 + nn;
        lds[nn * 65 + kk] = n < Nsrc ? src[(size_t)(kt * 64 + kk) * Nsrc + n] : 0.f; }
    __syncthreads();
    const bool permw = item < 2 * P0_PER_LAYER;
    for (int idx = tid0; idx < 4096; idx += NTH) { const int nn = idx >> 6, kk = idx & 63; const bf16_t v = f2bf(lds[nn * 65 + kk]);
        const int c5 = nn & 31, nrow = permw ? (nn & 32) + 16 * ((c5 >> 2) & 1) + 4 * (c5 >> 3) + (c5 & 3) : nn;
        for (int c = 0; c < copies; ++c) dst[(size_t)(nt * 64 + nrow) * ldd + c * 1024 + kt * 64 + kk] = v; }
    __syncthreads();
}

__device__ void pn_range(const Params& p, int l, int g, int m0r, int m1r, int mstep) {
    const int tid0 = otid(), wave = tid0 >> 6, lane = tid0 & 63;
    bf16_t* U = (bf16_t*)(p.ws + WS_U); const float* pw = p.pre_w + l * DM;
    for (int m = m0r + wave; m < m1r; m += mstep) {
        const int b = g * GB + m / LL, t = m % LL; const float* h = h_in_row(p, l, b, t);
        f32x4 v[4]; float ss = 0.f;
#pragma unroll
        for (int i = 0; i < 4; ++i) { v[i] = *(const f32x4*)(h + (lane + 64 * i) * 4); ss += v[i][0] * v[i][0] + v[i][1] * v[i][1] + v[i][2] * v[i][2] + v[i][3] * v[i][3]; }
        ss = wsum(ss); const float rn = rsqrtf(ss * (1.0f / DM) + 1e-6f);
#pragma unroll
        for (int i = 0; i < 4; ++i) { const f32x4 w = *(const f32x4*)(pw + (lane + 64 * i) * 4); u32x2 o; o.x = pk2(v[i][0] * rn * w[0], v[i][1] * rn * w[1]); o.y = pk2(v[i][2] * rn * w[2], v[i][3] * rn * w[3]);
            *(u32x2*)(U + (size_t)m * DM + (lane + 64 * i) * 4) = o; }
    }
}

__device__ void pn_phase(const Params& p, int l, int g) { pn_range(p, l, g, obid() * 8, MG, (int)gridDim.x * 8); }

constexpr int BK = 64, HALF = 128, HT = HALF * BK;
__device__ __forceinline__ int lds_byte(int r, int c) { int st = (r >> 4) * 2 + (c >> 5), rr = r & 15, cc = c & 31, ob = rr * 64 + cc * 2; return st * 1024 + (ob ^ (((ob >> 9) & 1) << 5)); }
__device__ __forceinline__ void stage_rc(int b, int& R, int& C) { int st = b / 1024, sb = b % 1024, swz = sb ^ (((sb >> 9) & 1) << 5); R = (st >> 1) * 16 + swz / 64; C = (st & 1) * 32 + (swz % 64) / 2; }

#define LAS __attribute__((address_space(3)))
template <class Epi>
__device__ __forceinline__ void gemm_unit(const bf16_t* A, int lda, int M, const bf16_t* Bt, int ldb, int nt, int brow, int bcol, unsigned char* shm_, const Epi& epi) {
    LAS unsigned char* lds = (LAS unsigned char*)shm_;
    const int tid = otid(), wid = __builtin_amdgcn_readfirstlane(tid >> 6), lane = tid & 63, wr = wid >> 2, wc = wid & 3, fr = lane & 15, fq = lane >> 4;
    unsigned voffA[2], voffB[2];
#pragma unroll
    for (int i = 0; i < 2; ++i) { int R, C; stage_rc(tid * 16 + i * 8192, R, C); voffA[i] = (unsigned)(R * lda + C) * 2u; voffB[i] = (unsigned)(R * ldb + C) * 2u; }
    const size_t kstep = (size_t)(BK * 2), hA = (size_t)HALF * lda * 2, hB = (size_t)HALF * ldb * 2;
    const unsigned ldsw = (unsigned)wid * 1024u;
    const int aoff = lds_byte(wr * 64 + fr, fq * 8), boff = lds_byte(wc * 32 + fr, fq * 8);
    const char* cA = (const char*)(A + (size_t)brow * lda); const char* cB = (const char*)(Bt + (size_t)bcol * ldb);
#define SA(b, h) (((b) * 2 + (h)) * (HT * 2))
#define SB(b, h) ((4 + (b) * 2 + (h)) * (HT * 2))
#define STAGE(bufoff, gbase, voff) do { _Pragma("unroll") for (int _i = 0; _i < 2; ++_i) \
        __builtin_amdgcn_global_load_lds((const unsigned*)((const char*)(gbase) + (voff)[_i]), (LAS unsigned*)(lds + (bufoff) + ldsw + _i * 8192), 16, 0, 0); } while (0)
#define LDA(dst, b, h) do { _Pragma("unroll") for (int m = 0; m < 4; ++m) _Pragma("unroll") for (int k = 0; k < 2; ++k) dst[m][k] = *(const LAS bf16x8*)(lds + SA(b, h) + aoff + m * 2048 + k * 1024); } while (0)
#define LDB(dst, b, h) do { _Pragma("unroll") for (int n = 0; n < 2; ++n) _Pragma("unroll") for (int k = 0; k < 2; ++k) dst[n][k] = *(const LAS bf16x8*)(lds + SB(b, h) + boff + n * 2048 + k * 1024); } while (0)
#define MMA(ai, bj, At_, Bt_) do { __builtin_amdgcn_s_setprio(1); _Pragma("unroll") for (int m = 0; m < 4; ++m) _Pragma("unroll") for (int n = 0; n < 2; ++n) _Pragma("unroll") for (int k = 0; k < 2; ++k) \
      acc[ai][bj][m][n] = __builtin_amdgcn_mfma_f32_16x16x32_bf16(Bt_[n][k], At_[m][k], acc[ai][bj][m][n], 0, 0, 0); \
    __builtin_amdgcn_s_setprio(0); } while (0)
#define WAIT_V(n) asm volatile("s_waitcnt vmcnt(" #n ")" ::: "memory")
#define WAIT_L(n) asm volatile("s_waitcnt lgkmcnt(" #n ")" ::: "memory")
#define BAR __builtin_amdgcn_s_barrier()
#define SCHED __builtin_amdgcn_sched_barrier(0)
    f32x4 acc[2][2][4][2];
#pragma unroll
    for (int a = 0; a < 2; ++a)
#pragma unroll
        for (int b = 0; b < 2; ++b)
#pragma unroll
            for (int m = 0; m < 4; ++m)
#pragma unroll
                for (int n = 0; n < 2; ++n) acc[a][b][m][n] = (f32x4){0.f, 0.f, 0.f, 0.f};
    bf16x8 At[4][2], B0[2][2], B1[2][2];
    STAGE(SB(0, 0), cB, voffB); STAGE(SA(0, 0), cA, voffA); STAGE(SB(0, 1), cB + hB, voffB); STAGE(SA(0, 1), cA + hA, voffA);
    if (wr == 1) BAR;
    WAIT_V(4); BAR;
    STAGE(SB(1, 0), cB + kstep, voffB); STAGE(SA(1, 0), cA + kstep, voffA); STAGE(SB(1, 1), cB + hB + kstep, voffB);
    WAIT_V(6); BAR;
    for (int t = 0; t < nt - 2; t += 2) {
        const char* a1 = cA + (size_t)(t + 1) * kstep; const char* a2 = a1 + kstep; const char* b2 = cB + (size_t)(t + 2) * kstep; const char* a3 = a2 + kstep; const char* b3 = b2 + kstep;
        LDB(B0, 0, 0); SCHED; LDA(At, 0, 0); STAGE(SA(1, 1), a1 + hA, voffA);
        WAIT_L(8); BAR; WAIT_L(0); MMA(0, 0, At, B0); BAR; SCHED;
        LDB(B1, 0, 1); STAGE(SB(0, 0), b2, voffB);
        BAR; WAIT_L(0); MMA(0, 1, At, B1); BAR;
        LDA(At, 0, 1); STAGE(SA(0, 0), a2, voffA);
        BAR; WAIT_L(0); MMA(1, 0, At, B0); BAR; SCHED;
        STAGE(SB(0, 1), b2 + hB, voffB);
        WAIT_V(6); BAR; MMA(1, 1, At, B1); BAR;
        LDB(B0, 1, 0); SCHED; LDA(At, 1, 0); STAGE(SA(0, 1), a2 + hA, voffA);
        WAIT_L(8); BAR; WAIT_L(0); MMA(0, 0, At, B0); BAR; SCHED;
        LDB(B1, 1, 1); STAGE(SB(1, 0), b3, voffB);
        BAR; WAIT_L(0); MMA(0, 1, At, B1); BAR;
        LDA(At, 1, 1); STAGE(SA(1, 0), a3, voffA);
        BAR; WAIT_L(0); MMA(1, 0, At, B0); BAR; SCHED;
        STAGE(SB(1, 1), b3 + hB, voffB);
        WAIT_V(6); BAR; MMA(1, 1, At, B1); BAR;
    }
    { LDB(B0, 0, 0); LDA(At, 0, 0); STAGE(SA(1, 1), cA + (size_t)(nt - 1) * kstep + hA, voffA);
      BAR; WAIT_L(0); MMA(0, 0, At, B0); BAR;
      LDB(B1, 0, 1); BAR; WAIT_L(0); MMA(0, 1, At, B1); BAR;
      LDA(At, 0, 1); WAIT_V(4); BAR; WAIT_L(0); MMA(1, 0, At, B0); MMA(1, 1, At, B1); BAR; }
    { LDB(B0, 1, 0); LDA(At, 1, 0); WAIT_V(2); BAR; WAIT_L(0); MMA(0, 0, At, B0); BAR;
      LDB(B1, 1, 1); WAIT_V(0); BAR; WAIT_L(0); MMA(0, 1, At, B1); BAR;
      LDA(At, 1, 1); BAR; WAIT_L(0); MMA(1, 0, At, B0); MMA(1, 1, At, B1); BAR; }
    if (wr == 0) BAR;
#pragma unroll
    for (int ai = 0; ai < 2; ++ai)
#pragma unroll
        for (int m = 0; m < 4; ++m) { const int row = brow + ai * HALF + wr * 64 + m * 16 + fr;
            if (row < M) {
#pragma unroll
                for (int bj = 0; bj < 2; ++bj) epi(row, bcol + bj * HALF + wc * 32 + fq * 8, acc[ai][bj][m][0], acc[ai][bj][m][1], epi.pre(row, bcol + bj * HALF + wc * 32 + fq * 8)); } }
    __syncthreads();
#undef SA
#undef SB
#undef STAGE
}

struct EpiZ { typedef int Pre; bf16_t* Z; int br;
    __device__ __forceinline__ Pre pre(int, int) const { return 0; }
    __device__ __forceinline__ void operator()(int row, int col, const f32x4& v0, const f32x4& v1, Pre = 0) const { u32x4 o; o.x = pk2(v0[0], v0[1]); o.y = pk2(v0[2], v0[3]); o.z = pk2(v1[0], v1[1]); o.w = pk2(v1[2], v1[3]); *(u32x4*)(Z + (size_t)row * ZS + col) = o; } };
struct EpiGate { typedef u32x4 Pre; const bf16_t* Z; bf16_t* Gd; int br;
    __device__ __forceinline__ Pre pre(int row, int col) const { return *(const u32x4*)(Z + (size_t)row * ZS + C_MG + br * 1024 + col); }
    __device__ __forceinline__ void operator()(int row, int col, const f32x4& v0, const f32x4& v1, Pre g) const { u32x4 o;
        o.x = pk2(v0[0] * sigm(lo2f(g.x)), v0[1] * sigm(hi2f(g.x))); o.y = pk2(v0[2] * sigm(lo2f(g.y)), v0[3] * sigm(hi2f(g.y)));
        o.z = pk2(v1[0] * sigm(lo2f(g.z)), v1[1] * sigm(hi2f(g.z))); o.w = pk2(v1[2] * sigm(lo2f(g.w)), v1[3] * sigm(hi2f(g.w)));
        *(u32x4*)(Gd + (size_t)row * 3072 + br * 1024 + col) = o; } };
struct EpiT { typedef int Pre; float* T; int br;
    __device__ __forceinline__ Pre pre(int, int) const { return 0; }
    __device__ __forceinline__ void operator()(int row, int col, const f32x4& v0, const f32x4& v1, Pre = 0) const { *(f32x4*)(T + (size_t)row * DM + col) = v0; *(f32x4*)(T + (size_t)row * DM + col + 4) = v1; } };

struct UnitDesc { const bf16_t* A; const bf16_t* Bt; int brow, bcol, br; };
template <class Enum, class Epi>
__device__ __forceinline__ void gemm_stream(const Enum& en, Epi epi, int lda, int M, int ldb, int nt, unsigned char* shm_) {
    LAS unsigned char* lds = (LAS unsigned char*)shm_;
    const int tid = otid(), wid = __builtin_amdgcn_readfirstlane(tid >> 6), lane = tid & 63, wr = wid >> 2, wc = wid & 3, fr = lane & 15, fq = lane >> 4;
    UnitDesc cur, nxt; int ui = 0;
    if (!en.get(0, cur)) return;
    unsigned voffA[2], voffB[2];
#pragma unroll
    for (int i = 0; i < 2; ++i) { int R, C; stage_rc(tid * 16 + i * 8192, R, C); voffA[i] = (unsigned)(R * lda + C) * 2u; voffB[i] = (unsigned)(R * ldb + C) * 2u; }
    const size_t kstep = (size_t)(BK * 2), hA = (size_t)HALF * lda * 2, hB = (size_t)HALF * ldb * 2;
    const unsigned ldsw = (unsigned)wid * 1024u;
    const int aoff = lds_byte(wr * 64 + fr, fq * 8), boff = lds_byte(wc * 32 + fr, fq * 8);
#define SA(b, h) (((b) * 2 + (h)) * (HT * 2))
#define SB(b, h) ((4 + (b) * 2 + (h)) * (HT * 2))
#define STAGE(bufoff, gbase, voff) do { _Pragma("unroll") for (int _i = 0; _i < 2; ++_i) \
        __builtin_amdgcn_global_load_lds((const unsigned*)((const char*)(gbase) + (voff)[_i]), (LAS unsigned*)(lds + (bufoff) + ldsw + _i * 8192), 16, 0, 0); } while (0)
    f32x4 acc[2][2][4][2];
#pragma unroll
    for (int a = 0; a < 2; ++a)
#pragma unroll
        for (int b = 0; b < 2; ++b)
#pragma unroll
            for (int m = 0; m < 4; ++m)
#pragma unroll
                for (int n = 0; n < 2; ++n) acc[a][b][m][n] = (f32x4){0.f, 0.f, 0.f, 0.f};
    bf16x8 At[4][2], B0[2][2], B1[2][2];
    const char* cA = (const char*)(cur.A + (size_t)cur.brow * lda); const char* cB = (const char*)(cur.Bt + (size_t)cur.bcol * ldb);
    STAGE(SB(0, 0), cB, voffB); STAGE(SA(0, 0), cA, voffA); STAGE(SB(0, 1), cB + hB, voffB); STAGE(SA(0, 1), cA + hA, voffA);
    if (wr == 1) BAR;
    WAIT_V(4); BAR;
    STAGE(SB(1, 0), cB + kstep, voffB); STAGE(SA(1, 0), cA + kstep, voffA); STAGE(SB(1, 1), cB + hB + kstep, voffB);
    WAIT_V(6); BAR;
    for (;;) {
        const bool has_next = en.get(ui + 1, nxt);
        const char* nA = has_next ? (const char*)(nxt.A + (size_t)nxt.brow * lda) : cA; const char* nB = has_next ? (const char*)(nxt.Bt + (size_t)nxt.bcol * ldb) : cB;
        for (int t = 0; t < nt; t += 2) {
            const bool last = (t == nt - 2);
            const char* a1 = cA + (size_t)(t + 1) * kstep;
            const char* a2 = last ? nA : cA + (size_t)(t + 2) * kstep; const char* b2 = last ? nB : cB + (size_t)(t + 2) * kstep;
            const char* a3 = a2 + kstep; const char* b3 = b2 + kstep;
            LDB(B0, 0, 0); SCHED; LDA(At, 0, 0); STAGE(SA(1, 1), a1 + hA, voffA);
            WAIT_L(8); BAR; WAIT_L(0); MMA(0, 0, At, B0); BAR; SCHED;
            LDB(B1, 0, 1); STAGE(SB(0, 0), b2, voffB);
            BAR; WAIT_L(0); MMA(0, 1, At, B1); BAR;
            LDA(At, 0, 1); STAGE(SA(0, 0), a2, voffA);
            BAR; WAIT_L(0); MMA(1, 0, At, B0); BAR; SCHED;
            STAGE(SB(0, 1), b2 + hB, voffB);
            WAIT_V(6); BAR; MMA(1, 1, At, B1); BAR;
            LDB(B0, 1, 0); SCHED; LDA(At, 1, 0); STAGE(SA(0, 1), a2 + hA, voffA);
            WAIT_L(8); BAR; WAIT_L(0); MMA(0, 0, At, B0); BAR; SCHED;
            LDB(B1, 1, 1); STAGE(SB(1, 0), b3, voffB);
            BAR; WAIT_L(0); MMA(0, 1, At, B1); BAR;
            LDA(At, 1, 1); STAGE(SA(1, 0), a3, voffA);
            BAR; WAIT_L(0); MMA(1, 0, At, B0); BAR; SCHED;
            STAGE(SB(1, 1), b3 + hB, voffB);
            WAIT_V(6); BAR; MMA(1, 1, At, B1); BAR;
        }
        epi.br = cur.br;
        { typename Epi::Pre pre[2][4][2];
#pragma unroll
            for (int ai = 0; ai < 2; ++ai)
#pragma unroll
                for (int m = 0; m < 4; ++m) { const int row = cur.brow + ai * HALF + wr * 64 + m * 16 + fr; const int rc = row < M ? row : M - 1;
#pragma unroll
                    for (int bj = 0; bj < 2; ++bj) pre[ai][m][bj] = epi.pre(rc, cur.bcol + bj * HALF + wc * 32 + fq * 8); }
#pragma unroll
            for (int ai = 0; ai < 2; ++ai)
#pragma unroll
                for (int m = 0; m < 4; ++m) { const int row = cur.brow + ai * HALF + wr * 64 + m * 16 + fr;
                    if (row < M) {
#pragma unroll
                        for (int bj = 0; bj < 2; ++bj) epi(row, cur.bcol + bj * HALF + wc * 32 + fq * 8, acc[ai][bj][m][0], acc[ai][bj][m][1], pre[ai][m][bj]); } } }
        if (!has_next) break;
#pragma unroll
        for (int a = 0; a < 2; ++a)
#pragma unroll
            for (int b = 0; b < 2; ++b)
#pragma unroll
                for (int m = 0; m < 4; ++m)
#pragma unroll
                    for (int n = 0; n < 2; ++n) acc[a][b][m][n] = (f32x4){0.f, 0.f, 0.f, 0.f};
        cur = nxt; cA = nA; cB = nB; ++ui;
    }
    WAIT_V(0);
    if (wr == 0) BAR;
    BAR;
    __syncthreads();
#undef SA
#undef SB
#undef STAGE
}
struct Enum1 { const bf16_t* U; const bf16_t* W; int x, j, nj;
    __device__ __forceinline__ bool get(int i, UnitDesc& u) const { const int v = j + nj * i; int pm, pn;
        if (v < 244) { pn = v >> 2; pm = x + 8 * (v & 3); } else { pn = x + 8 * (v - 244); pm = 32; if (pn >= 61) return false; }
        u.A = U; u.Bt = W; u.brow = pm * 256; u.bcol = pn * 256; u.br = 0; return true; } };
struct Enum1m { const bf16_t* U; const bf16_t* W; int x, j, nj, merged;
    __device__ __forceinline__ bool get(int i, UnitDesc& u) const { int v, pm, pn;
        if (!merged) v = j + nj * i;
        else if (j < 17) { if (i >= 7) return false; v = j + 32 * i; }
        else { if (i < 7) v = j + 32 * i; else if (i < 9) v = 224 + (j - 17) + 15 * (i - 7); else return false; }
        if (v < 244) { pn = v >> 2; pm = x + 8 * (v & 3); } else { pn = x + 8 * (v - 244); pm = 32; if (pn >= 61) return false; }
        u.A = U; u.Bt = W; u.brow = pm * 256; u.bcol = pn * 256; u.br = 0; return true; } };
struct Enum4 { const bf16_t* Z; const bf16_t* Wl; int x, j, nj;
    __device__ __forceinline__ bool get(int i, UnitDesc& u) const { const int v = j + nj * i; int br, pm, pn;
        if (v < 48) { br = v >> 4; pn = (v >> 2) & 3; pm = x + 8 * (v & 3); } else { const int e = x + 8 * (v - 48); if (e >= 12) return false; br = e >> 2; pn = e & 3; pm = 32; }
        u.A = Z + (br == 0 ? C_AQ : br == 1 ? C_RR : C_HQ); u.Bt = Wl + (size_t)br * 1024 * 1024; u.brow = pm * 256; u.bcol = pn * 256; u.br = br; return true; } };
struct Enum5 { const bf16_t* Gt; const bf16_t* Wl; int x, j, nj;
    __device__ __forceinline__ bool get(int i, UnitDesc& u) const { const int v = j + nj * i; int pm, pn;
        if (v < 16) { pn = v >> 2; pm = x + 8 * (v & 3); } else { const int e = x + 8 * (v - 16); if (e >= 4) return false; pn = e; pm = 32; }
        u.A = Gt; u.Bt = Wl; u.brow = pm * 256; u.bcol = pn * 256; u.br = 0; return true; } };

__device__ void rope_phase(const Params& p) {
    const int tid0 = otid(), bid0 = obid(), wave = tid0 >> 6, lane = tid0 & 63, d = lane & 31, qk = lane >> 5;
    bf16_t* Z = (bf16_t*)(p.ws + WS_Z);
    const float inv = 1.0f / powf(10000.0f, (float)(2 * d) / 64.0f);
    for (int m = bid0 * 8 + wave; m < MG; m += gridDim.x * 8) {
        const int t = m % LL; const float ang = (float)t * inv; float sn, cs; sincosf(ang, &sn, &cs);
        const float sc = qk == 0 ? 0.125f : 1.0f;
        bf16_t* base = Z + (size_t)m * ZS + qk * 1024 + d;
        bf16_t r1[16], r2[16];
#pragma unroll
        for (int hh = 0; hh < 16; ++hh) { r1[hh] = base[hh * 64]; r2[hh] = base[hh * 64 + 32]; }
#pragma unroll
        for (int hh = 0; hh < 16; ++hh) { const float x1 = bf2f(r1[hh]), x2 = bf2f(r2[hh]);
            base[hh * 64] = f2bf((x1 * cs - x2 * sn) * sc); base[hh * 64 + 32] = f2bf((x2 * cs + x1 * sn) * sc); }
    }
}

constexpr int NCH = 65;
constexpr int RC_VT = 18 * 1024, RC_SG = RC_VT + 4096, RC_BON = RC_SG + 4096, RC_BYTES = RC_BON + 256;
static_assert((size_t)64 * NCH * RC_BYTES <= WS_HM - WS_P, "chunk records overflow");
constexpr int WLDS = 19968;

__device__ __forceinline__ float half_sum(float v) {
    v = row16_sum(v); v += xor_lane<16>(v); return v;
}

__device__ void rwkv_summary(const Params& p, int l, int item, unsigned char* wl, int lane) {
    const int chain = item / NCH, ci = item % NCH, bl = chain >> 4, h = chain & 15, m0 = bl * LL, c0 = ci * 32, l31 = lane & 31, hh = lane >> 5;
    const bf16_t* Z = (const bf16_t*)(p.ws + WS_Z);
    unsigned char* rec = p.ws + WS_P + (size_t)item * RC_BYTES;
    const float* mu = p.mu + l * 4224;
    f32x16 dlo[2], alo[2];
#pragma unroll
    for (int nt = 0; nt < 2; ++nt)
#pragma unroll
        for (int r = 0; r < 16; ++r) { dlo[nt][r] = 0.f; alo[nt][r] = 0.f; }
    {
        const int t = c0 + l31, tc = t < LL ? t : LL - 1; const bf16_t* zr = Z + (size_t)(m0 + tc) * ZS;
        const bf16_t* WT = (const bf16_t*)(p.ws + WS_LR) + (size_t)(l * 2) * 65536; const bf16_t* AT = WT + 65536;
#pragma unroll
        for (int st = 0; st < 4; ++st) { const int j0 = 8 * hh + 16 * st;
            const u32x4 cw = *(const u32x4*)(zr + C_RWD + j0), ca = *(const u32x4*)(zr + C_RAD + j0);
            u32x4 pw = {0u, 0u, 0u, 0u}, pa = {0u, 0u, 0u, 0u}; if (tc > 0) { pw = *(const u32x4*)(zr - ZS + C_RWD + j0); pa = *(const u32x4*)(zr - ZS + C_RAD + j0); }
            u32x4 fw, fa;
#pragma unroll
            for (int q = 0; q < 4; ++q) { const float m0w = mu[4096 + j0 + 2 * q], m1w = mu[4096 + j0 + 2 * q + 1], m0a = mu[4160 + j0 + 2 * q], m1a = mu[4160 + j0 + 2 * q + 1];
                const float c0w = lo2f(cw[q]), c1w = hi2f(cw[q]), c0a = lo2f(ca[q]), c1a = hi2f(ca[q]);
                fw[q] = pk2(tanh_fast(c0w + (lo2f(pw[q]) - c0w) * m0w), tanh_fast(c1w + (hi2f(pw[q]) - c1w) * m1w));
                fa[q] = pk2(c0a + (lo2f(pa[q]) - c0a) * m0a, c1a + (hi2f(pa[q]) - c1a) * m1a); }
#pragma unroll
            for (int nt = 0; nt < 2; ++nt) { const size_t wo = (size_t)(h * 64 + 32 * nt + l31) * 64 + j0;
                dlo[nt] = mfma32(__builtin_bit_cast(bf16x8, fw), *(const bf16x8*)(WT + wo), dlo[nt]);
                alo[nt] = mfma32(__builtin_bit_cast(bf16x8, fa), *(const bf16x8*)(AT + wo), alo[nt]); }
            __builtin_amdgcn_sched_barrier(0); }
    }
    float KK[2][16], KT[2][16], XR[2][16];
    float gamC[2];
#pragma unroll
    for (int nt = 0; nt < 2; ++nt) {
        const int c = h * 64 + 32 * nt + l31; const int pc = l * 1024 + c;
        const float w0 = p.w0[pc], a0 = p.a0[pc], kkc = p.k_k[pc], kac = p.k_a[pc], mr = mu[c], mk = mu[1024 + c], mv = mu[2048 + c], mgc = mu[3072 + c];
#pragma unroll
        for (int q = 0; q < 4; ++q) { float xv4[4], sg4[4];
#pragma unroll
            for (int e = 0; e < 4; ++e) { const int r = 4 * q + e, tt = 8 * q + 4 * hh + e, t = c0 + tt; const bool valid = t < LL; const int tc = valid ? t : LL - 1;
                const bf16_t* zr = Z + (size_t)(m0 + tc) * ZS + c;
                const float r0 = bf2f(zr[C_RR]), k0 = bf2f(zr[C_RK]), v0 = bf2f(zr[C_RV]), g0 = bf2f(zr[C_RG]);
                float rp = 0.f, kp = 0.f, vp = 0.f, gp = 0.f; if (tc > 0) { rp = bf2f(zr[C_RR - ZS]); kp = bf2f(zr[C_RK - ZS]); vp = bf2f(zr[C_RV - ZS]); gp = bf2f(zr[C_RG - ZS]); }
                float xr = r0 + (rp - r0) * mr, xk = k0 + (kp - k0) * mk, xv = v0 + (vp - v0) * mv; const float xg = g0 + (gp - g0) * mgc;
                const float y = -(w0 + dlo[nt][r]); const float sp = y > 20.f ? y : __logf(1.0f + __expf(y));
                float lw = -__expf(-sp - 0.5f);
                const float al = sigm(a0 + alo[nt][r]);
                if (!valid) { xr = 0.f; xk = 0.f; xv = 0.f; lw = 0.f; }
                dlo[nt][r] = lw; alo[nt][r] = al; XR[nt][r] = xr; KK[nt][r] = xk * kkc; KT[nt][r] = xk * (1.0f + (al - 1.0f) * kac);
                xv4[e] = xv; sg4[e] = silu(xg); }
            u32x2 o; o.x = pk2(xv4[0], xv4[1]); o.y = pk2(xv4[2], xv4[3]); *(u32x2*)(rec + RC_VT + (32 * nt + l31) * 64 + (8 * q + 4 * hh) * 2) = o;
            o.x = pk2(sg4[0], sg4[1]); o.y = pk2(sg4[2], sg4[3]); *(u32x2*)(rec + RC_SG + (32 * nt + l31) * 64 + (8 * q + 4 * hh) * 2) = o;
            if (q & 1) __builtin_amdgcn_sched_barrier(0); }
    }
    {
        const float rk0 = p.r_k[l * 1024 + h * 64 + l31], rk1 = p.r_k[l * 1024 + h * 64 + 32 + l31];
#pragma unroll
        for (int r = 0; r < 16; ++r) { const float ss = half_sum(KK[0][r] * KK[0][r] + KK[1][r] * KK[1][r]); const float inv = rsqrtf(fmaxf(ss, 1e-24f)); KK[0][r] *= inv; KK[1][r] *= inv;
            const float bon = half_sum(XR[0][r] * KT[0][r] * rk0 + XR[1][r] * KT[1][r] * rk1);
            if (l31 == 0) ((bf16_t*)(rec + RC_BON))[(r & 3) + 8 * (r >> 2) + 4 * hh] = f2bf(bon); }
    }
#pragma unroll
    for (int nt = 0; nt < 2; ++nt) { float tot[4], ptot[4];
#pragma unroll
        for (int q = 0; q < 4; ++q) { dlo[nt][4 * q + 1] += dlo[nt][4 * q]; dlo[nt][4 * q + 2] += dlo[nt][4 * q + 1]; dlo[nt][4 * q + 3] += dlo[nt][4 * q + 2]; tot[q] = dlo[nt][4 * q + 3]; }
#pragma unroll
        for (int q = 0; q < 4; ++q) ptot[q] = __shfl_xor(tot[q], 32);
        float off = 0.f;
#pragma unroll
        for (int q = 0; q < 4; ++q) { const float t0 = hh ? ptot[q] : tot[q], t1 = hh ? tot[q] : ptot[q]; const float mine = off + (hh ? t0 : 0.f);
#pragma unroll
            for (int e = 0; e < 4; ++e) dlo[nt][4 * q + e] += mine;
            off += t0 + t1; }
        gamC[nt] = off; }
    bf16_t* Bh = (bf16_t*)wl; bf16_t* Kh = Bh + 32 * 72; bf16_t* Atl = Kh + 32 * 72; bf16_t* Rt = Atl + 32 * 72;
    u32x4* kstash = (u32x4*)(rec + 8 * 1024);
#pragma unroll
    for (int nt = 0; nt < 2; ++nt) { unsigned aw[8], bw[8], kw[8];
#pragma unroll
        for (int q = 0; q < 4; ++q) {
            const float plast = __shfl_xor(dlo[nt][4 * q + 3], 32); const float plastp = q > 0 ? __shfl_xor(dlo[nt][4 * (q > 0 ? q - 1 : 0) + 3], 32) : 0.f;
            float prevc = hh ? plast : plastp; float at[4], bc[4], kc[4];
#pragma unroll
            for (int e = 0; e < 4; ++e) { const int r = 4 * q + e, tt = 8 * q + 4 * hh + e; const float cum = dlo[nt][r];
                const float g = __expf(cum), ig = __expf(-cum), gce = __expf(gamC[nt] - cum), gp = __expf(prevc); prevc = cum;
                const float bb = KK[nt][r] * alo[nt][r];
                at[e] = -KK[nt][r] * gp; bc[e] = bb * gce; kc[e] = KT[nt][r] * gce;
                Bh[tt * 72 + 32 * nt + l31] = f2bf(bb * ig); Kh[tt * 72 + 32 * nt + l31] = f2bf(KT[nt][r] * ig); Rt[tt * 72 + 32 * nt + l31] = f2bf(XR[nt][r] * g); Atl[tt * 72 + 32 * nt + l31] = f2bf(at[e]); }
            aw[2 * q] = pk2(at[0], at[1]); aw[2 * q + 1] = pk2(at[2], at[3]); bw[2 * q] = pk2(bc[0], bc[1]); bw[2 * q + 1] = pk2(bc[2], bc[3]);
            kw[2 * q] = pk2(kc[0], kc[1]); kw[2 * q + 1] = pk2(kc[2], kc[3]);
            __builtin_amdgcn_sched_barrier(0); }
#pragma unroll
        for (int st = 0; st < 2; ++st) { u32x4 wa, wb; wa.x = aw[4 * st]; wa.y = aw[4 * st + 1]; wa.z = aw[4 * st + 2]; wa.w = aw[4 * st + 3]; wb.x = bw[4 * st]; wb.y = bw[4 * st + 1]; wb.z = bw[4 * st + 2]; wb.w = bw[4 * st + 3];
            ((u32x4*)rec)[(nt * 2 + st) * 64 + lane] = wa; ((u32x4*)rec)[(4 + nt * 2 + st) * 64 + lane] = wb;
            u32x4 wk; wk.x = kw[4 * st]; wk.y = kw[4 * st + 1]; wk.z = kw[4 * st + 2]; wk.w = kw[4 * st + 3]; kstash[(nt * 2 + st) * 64 + lane] = wk; }
    }
    const float gC0 = __expf(gamC[0]), gC1 = __expf(gamC[1]);
    asm volatile("s_waitcnt lgkmcnt(0)" ::: "memory");
    f32x16 Nab, Nak, Mbr, Mkr;
#pragma unroll
    for (int r = 0; r < 16; ++r) { Nab[r] = 0.f; Nak[r] = 0.f; Mbr[r] = 0.f; Mkr[r] = 0.f; }
#pragma unroll
    for (int st = 0; st < 4; ++st) { const int o = l31 * 72 + 8 * hh + 16 * st;
        const bf16x8 fb = *(const bf16x8*)(Bh + o), fk = *(const bf16x8*)(Kh + o), fa = *(const bf16x8*)(Atl + o), fr = *(const bf16x8*)(Rt + o);
        Nab = mfma32(fb, fa, Nab); Nak = mfma32(fk, fa, Nak); Mbr = mfma32(fb, fr, Mbr); Mkr = mfma32(fk, fr, Mkr); }
    f32x16 Rp[2];
#pragma unroll
    for (int mt = 0; mt < 2; ++mt)
#pragma unroll
        for (int q = 0; q < 4; ++q) { const u32x2 v = *(const u32x2*)(Rt + l31 * 72 + 32 * mt + 8 * q + 4 * hh);
            Rp[mt][4 * q] = lo2f(v.x); Rp[mt][4 * q + 1] = hi2f(v.x); Rp[mt][4 * q + 2] = lo2f(v.y); Rp[mt][4 * q + 3] = hi2f(v.y); }
#pragma unroll
    for (int r = 0; r < 16; ++r) { const int s = (r & 3) + 8 * (r >> 2) + 4 * hh; if (s >= l31) { Nab[r] = 0.f; Nak[r] = 0.f; } if (s > l31) { Mbr[r] = 0.f; Mkr[r] = 0.f; } }
    asm volatile("s_waitcnt lgkmcnt(0)" ::: "memory");
    float* Nl = (float*)wl; bf16_t* NakL = (bf16_t*)(wl + 4096);
#pragma unroll
    for (int r = 0; r < 16; ++r) { const int s = (r & 3) + 8 * (r >> 2) + 4 * hh; Nl[s * 32 + l31] = Nab[r]; NakL[s * 40 + l31] = f2bf(Nak[r]); }
    asm volatile("s_waitcnt lgkmcnt(0)" ::: "memory");
    float T[32];
#pragma unroll
    for (int s = 31; s >= 0; --s) { float acc = (s == l31) ? 1.0f : 0.0f;
#pragma unroll
        for (int s2 = s + 1; s2 < 32; ++s2) acc += Nl[s * 32 + s2] * T[s2];
        T[s] = acc; if ((s & 3) == 0) __builtin_amdgcn_sched_barrier(0); }
    bf16x8 Tf[2];
#pragma unroll
    for (int st = 0; st < 2; ++st) { u32x4 w;
#pragma unroll
        for (int q = 0; q < 4; ++q) { const int sa = 16 * st + 8 * (q >> 1) + 2 * (q & 1); w[q] = hh ? pk2(T[sa + 4], T[sa + 5]) : pk2(T[sa], T[sa + 1]); }
        Tf[st] = __builtin_bit_cast(bf16x8, w); }
    bf16x8 AtP[2][2], BcP[2][2];
#pragma unroll
    for (int nt = 0; nt < 2; ++nt)
#pragma unroll
        for (int st = 0; st < 2; ++st) { AtP[nt][st] = ((const bf16x8*)rec)[(nt * 2 + st) * 64 + lane]; BcP[nt][st] = ((const bf16x8*)rec)[(4 + nt * 2 + st) * 64 + lane]; }
    f32x16 ApT[2], W1T;
#pragma unroll
    for (int r = 0; r < 16; ++r) { ApT[0][r] = 0.f; ApT[1][r] = 0.f; W1T[r] = 0.f; }
#pragma unroll
    for (int st = 0; st < 2; ++st) { ApT[0] = mfma32(Tf[st], AtP[0][st], ApT[0]); ApT[1] = mfma32(Tf[st], AtP[1][st], ApT[1]);
        const bf16_t* nk = NakL + l31 * 40 + 16 * st + 4 * hh; W1T = mfma32(Tf[st], ld44(nk, nk + 8), W1T); }
    mfma_settle(ApT[0]); mfma_settle(ApT[1]); mfma_settle(W1T);
    bf16x8 ApF[2][2], W1F[2], MbF[2];
#pragma unroll
    for (int st = 0; st < 2; ++st) { ApF[0][st] = pack8(ApT[0], st); ApF[1][st] = pack8(ApT[1], st); W1F[st] = pack8(W1T, st); MbF[st] = pack8(Mbr, st); }
    bf16x8* out = (bf16x8*)rec;
#pragma unroll
    for (int jt = 0; jt < 2; ++jt) {
#pragma unroll
        for (int j2 = 0; j2 < 2; ++j2) { f32x16 G;
#pragma unroll
            for (int r = 0; r < 16; ++r) G[r] = (jt == j2 && ((r & 3) + 8 * (r >> 2) + 4 * hh) == l31) ? (j2 ? gC1 : gC0) : 0.f;
            G = mfma32(ApF[jt][0], BcP[j2][0], G); G = mfma32(ApF[jt][1], BcP[j2][1], G); mfma_settle(G);
            out[((jt * 2 + j2) * 2 + 0) * 64 + lane] = pack8(G, 0); out[((jt * 2 + j2) * 2 + 1) * 64 + lane] = pack8(G, 1); }
        Rp[jt] = mfma32(ApF[jt][0], MbF[0], Rp[jt]); Rp[jt] = mfma32(ApF[jt][1], MbF[1], Rp[jt]); mfma_settle(Rp[jt]);
        out[(12 + jt * 2 + 0) * 64 + lane] = pack8(Rp[jt], 0); out[(12 + jt * 2 + 1) * 64 + lane] = pack8(Rp[jt], 1); }
#pragma unroll
    for (int j2 = 0; j2 < 2; ++j2) { f32x16 H;
#pragma unroll
        for (int st = 0; st < 2; ++st) { const u32x4 wk = kstash[(j2 * 2 + st) * 64 + lane];
#pragma unroll
            for (int q = 0; q < 4; ++q) { H[8 * st + 2 * q] = lo2f(wk[q]); H[8 * st + 2 * q + 1] = hi2f(wk[q]); } }
        H = mfma32(W1F[0], BcP[j2][0], H); H = mfma32(W1F[1], BcP[j2][1], H); mfma_settle(H);
        out[(8 + j2 * 2 + 0) * 64 + lane] = pack8(H, 0); out[(8 + j2 * 2 + 1) * 64 + lane] = pack8(H, 1); }
    Mkr = mfma32(W1F[0], MbF[0], Mkr); Mkr = mfma32(W1F[1], MbF[1], Mkr); mfma_settle(Mkr);
    out[(16 + 0) * 64 + lane] = pack8(Mkr, 0); out[(16 + 1) * 64 + lane] = pack8(Mkr, 1);
    asm volatile("s_waitcnt lgkmcnt(0)" ::: "memory");
}

__device__ void rwkv_seq(const Params& p, int l, int chain, int it, int lane, float* ex, int cl, unsigned char* wstage) {
    LAS unsigned char* wl = (LAS unsigned char*)wstage;
    const int bl = chain >> 4, h = chain & 15, m0 = bl * LL, l31 = lane & 31, hh = lane >> 5;
    bf16_t* Z = (bf16_t*)(p.ws + WS_Z);
    f32x16 ST[2];
#pragma unroll
    for (int a = 0; a < 2; ++a)
#pragma unroll
        for (int r = 0; r < 16; ++r) ST[a][r] = 0.f;
    const float gw0 = p.gn_w[l * 1024 + h * 64 + 32 * it + l31], gb0 = p.gn_b[l * 1024 + h * 64 + 32 * it + l31];
    bf16x8 vb[2], vbn[2];
#define RW_LOAD(ci_) do { const unsigned char* rc_ = p.ws + WS_P + (size_t)(chain * NCH + (ci_)) * RC_BYTES; \
        _Pragma("unroll") for (int f = 0; f < 18; ++f) __builtin_amdgcn_global_load_lds((const unsigned*)(rc_ + f * 1024 + lane * 16), (LAS unsigned*)(wl + f * 1024), 16, 0, 0); \
        _Pragma("unroll") for (int st = 0; st < 2; ++st) { const bf16_t* vp_ = (const bf16_t*)(rc_ + RC_VT) + (32 * it + l31) * 32 + 16 * st + 4 * hh; \
            const u32x2 a_ = *(const u32x2*)vp_, b_ = *(const u32x2*)(vp_ + 8); u32x4 w_; w_.x = a_.x; w_.y = a_.y; w_.z = b_.x; w_.w = b_.y; vbn[st] = __builtin_bit_cast(bf16x8, w_); } } while (0)
    RW_LOAD(0); vb[0] = vbn[0]; vb[1] = vbn[1];
    for (int ci = 0; ci < NCH; ++ci) {
        const unsigned char* rec = p.ws + WS_P + (size_t)(chain * NCH + ci) * RC_BYTES;
        asm volatile("s_waitcnt vmcnt(0)" ::: "memory");
        bf16x8 fr[18];
#pragma unroll
        for (int f = 0; f < 18; ++f) fr[f] = *(const LAS bf16x8*)(wl + f * 1024 + lane * 16);
        bf16x8 sp[2][2];
#pragma unroll
        for (int jt = 0; jt < 2; ++jt) { sp[jt][0] = pack8(ST[jt], 0); sp[jt][1] = pack8(ST[jt], 1); }
        u32x2 ev[4], es[4], bon[4];
#pragma unroll
        for (int q = 0; q < 4; ++q) { ev[q] = *(const u32x2*)(rec + RC_VT + (32 * it + l31) * 64 + (8 * q + 4 * hh) * 2); es[q] = *(const u32x2*)(rec + RC_SG + (32 * it + l31) * 64 + (8 * q + 4 * hh) * 2);
            bon[q] = *(const u32x2*)(rec + RC_BON + (8 * q + 4 * hh) * 2); }
        asm volatile("s_waitcnt lgkmcnt(0)" ::: "memory");
        if (ci + 1 < NCH) RW_LOAD(ci + 1);
        f32x16 O;
#pragma unroll
        for (int r = 0; r < 16; ++r) O[r] = 0.f;
#pragma unroll
        for (int jt = 0; jt < 2; ++jt)
#pragma unroll
            for (int st = 0; st < 2; ++st) O = mfma32(fr[12 + jt * 2 + st], sp[jt][st], O);
#pragma unroll
        for (int st = 0; st < 2; ++st) O = mfma32(fr[16 + st], vb[st], O);
#pragma unroll
        for (int j2 = 0; j2 < 2; ++j2) { f32x16 Sn;
#pragma unroll
            for (int r = 0; r < 16; ++r) Sn[r] = 0.f;
#pragma unroll
            for (int jt = 0; jt < 2; ++jt)
#pragma unroll
                for (int st = 0; st < 2; ++st) Sn = mfma32(fr[(jt * 2 + j2) * 2 + st], sp[jt][st], Sn);
#pragma unroll
            for (int st = 0; st < 2; ++st) Sn = mfma32(fr[8 + j2 * 2 + st], vb[st], Sn);
            ST[j2] = Sn; }
        vb[0] = vbn[0]; vb[1] = vbn[1];
        float* exw = ex + ((ci & 1) * 8 + cl * 2) * 64;
        {
            float a[16], b[16];
#pragma unroll
            for (int r = 0; r < 16; ++r) { a[r] = O[r]; b[r] = O[r] * O[r]; }
#define RW_STEP(n, m) _Pragma("unroll") for (int k = 0; k < (n); ++k) { const bool up = (l31 & (m)) != 0; \
                const float ka = up ? a[k + (n)] : a[k], sa = up ? a[k] : a[k + (n)], kb = up ? b[k + (n)] : b[k], sb = up ? b[k] : b[k + (n)]; \
                a[k] = ka + xor_lane<(m)>(sa); b[k] = kb + xor_lane<(m)>(sb); }
            RW_STEP(8, 16) RW_STEP(4, 8) RW_STEP(2, 4) RW_STEP(1, 2)
#undef RW_STEP
            a[0] += xor_lane<1>(a[0]); b[0] += xor_lane<1>(b[0]);
            if ((l31 & 1) == 0) { const int r = l31 >> 1, tt = (r & 3) + 8 * (r >> 2) + 4 * hh; exw[it * 64 + tt * 2] = a[0]; exw[it * 64 + tt * 2 + 1] = b[0]; }
        }
        asm volatile("s_waitcnt lgkmcnt(0)" ::: "memory"); __builtin_amdgcn_s_barrier(); asm volatile("" ::: "memory");
        bf16_t* Zc = Z + (size_t)(m0 + ci * 32) * ZS + C_RR + h * 64 + 32 * it; const unsigned voff = (unsigned)(4 * hh) * ZS + l31;
#pragma unroll
        for (int q = 0; q < 4; ++q)
#pragma unroll
            for (int e = 0; e < 4; ++e) { const int r = 4 * q + e, tt = 8 * q + 4 * hh + e, t = ci * 32 + tt;
                const float ps1 = exw[tt * 2] + exw[64 + tt * 2], ps2 = exw[tt * 2 + 1] + exw[64 + tt * 2 + 1];
                const float mean = ps1 * (1.0f / 64.0f), var = fmaxf(ps2 * (1.0f / 64.0f) - mean * mean, 0.f);
                const float rs = rsqrtf(var + 64e-5f), d0 = O[r] - mean;
                const unsigned vv0 = e < 2 ? ev[q].x : ev[q].y, ss0 = e < 2 ? es[q].x : es[q].y;
                const float va = (e & 1) ? hi2f(vv0) : lo2f(vv0), sa = (e & 1) ? hi2f(ss0) : lo2f(ss0);
                const float y0 = (d0 * rs * gw0 + gb0 + ((e & 1) ? hi2f(e < 2 ? bon[q].x : bon[q].y) : lo2f(e < 2 ? bon[q].x : bon[q].y)) * va) * sa;
                if (t < LL) Zc[(unsigned)(8 * q + e) * ZS + voff] = f2bf(y0); }
    }
#undef RW_LOAD
}

constexpr size_t WS_HS = WS_P + (size_t)64 * NCH * RC_BYTES;
constexpr int HS_BYTES = 3072;
constexpr size_t WS_HL = WS_HS + (size_t)32 * NCH * HS_BYTES;
static_assert(WS_HL + (size_t)32 * 24576 <= WS_HM, "hgrn side records overflow");

__device__ __forceinline__ bf16_t* hfrag(const Params& p, int bl, int h, int ci, int arr, int f, int lane) {
    if (ci < 64) return (bf16_t*)(p.ws + WS_Z) + (size_t)(bl * LL + ci * 32 + 4 * f + (lane >> 4)) * ZS + (arr == 0 ? C_HQ : arr == 1 ? C_HF : C_HI) + h * 128 + (lane & 15) * 8;
    return (bf16_t*)(p.ws + WS_HL + (size_t)(bl * 8 + h) * 24576 + (arr * 8 + f) * 1024 + lane * 16);
}

__device__ void hgrn_summary(const Params& p, int l, int item, unsigned char* smem) {
    const int chain = item / NCH, ci = item % NCH, bl = chain >> 3, h = chain & 7, m0 = bl * LL, tid = otid(), w = tid >> 6, lane = tid & 63, l31 = lane & 31, hh = lane >> 5;
    float* Gf = (float*)smem; float* Qf = (float*)(smem + 16384); float* Kf = (float*)(smem + 32768); float* dec = (float*)(smem + 49152);
    bf16_t* Qh = (bf16_t*)(smem + 49664); bf16_t* Kc = (bf16_t*)(smem + 58368); bf16_t* KbT = (bf16_t*)(smem + 67072); bf16_t* VT = (bf16_t*)(smem + 77312);
    bf16_t* attL = (bf16_t*)(smem + 87552);
    const bf16_t* Z = (const bf16_t*)(p.ws + WS_Z);
    const int t0 = ci * 32;
    {
        const int tt = tid >> 4, k0 = (tid & 15) * 8, t = t0 + tt; const bool valid = t < LL; const int tc = valid ? t : LL - 1;
        bf16_t* zr = (bf16_t*)(p.ws + WS_Z) + (size_t)(m0 + tc) * ZS + h * 128 + k0;
        const u32x4 wq = *(const u32x4*)(zr + C_HQ), wf = *(const u32x4*)(zr + C_HF), wi = *(const u32x4*)(zr + C_HI), wg = *(const u32x4*)(zr + C_HG);
        f32x4 lb0 = {0.f, 0.f, 0.f, 0.f}, lb1 = {0.f, 0.f, 0.f, 0.f};
        if (l == 1) { const f32x4 a0 = *(const f32x4*)(p.hlb + h * 128 + k0), a1 = *(const f32x4*)(p.hlb + h * 128 + k0 + 4), b0 = *(const f32x4*)(p.hlb + 1024 + h * 128 + k0), b1 = *(const f32x4*)(p.hlb + 1024 + h * 128 + k0 + 4);
#pragma unroll
            for (int j = 0; j < 4; ++j) { lb0[j] = __builtin_amdgcn_rcpf(1.0f + __expf(a0[j] - b0[j])); lb1[j] = __builtin_amdgcn_rcpf(1.0f + __expf(a1[j] - b1[j])); } }
        float g[8], q[8], kk[8], sg[8];
#pragma unroll
        for (int j = 0; j < 8; ++j) { const unsigned uq = wq[j >> 1], uf = wf[j >> 1], ug = wg[j >> 1];
            const float hq = (j & 1) ? hi2f(uq) : lo2f(uq), hf = (j & 1) ? hi2f(uf) : lo2f(uf), hg = (j & 1) ? hi2f(ug) : lo2f(ug), lb = j < 4 ? lb0[j & 3] : lb1[j & 3];
            const float fg = lb + (1.0f - lb) * sigm(hf);
            g[j] = valid ? __logf(fg) : 0.f; q[j] = valid ? silu(hq) : 0.f; kk[j] = valid ? 1.0f - fg : 0.f; sg[j] = silu(hg);
            const unsigned ui = wi[j >> 1]; VT[(k0 + j) * 40 + tt] = valid ? (bf16_t)((j & 1) ? (ui >> 16) : (ui & 0xffffu)) : (bf16_t)0; }
        *(f32x4*)(Gf + tt * 128 + k0) = (f32x4){g[0], g[1], g[2], g[3]}; *(f32x4*)(Gf + tt * 128 + k0 + 4) = (f32x4){g[4], g[5], g[6], g[7]};
        *(f32x4*)(Qf + tt * 128 + k0) = (f32x4){q[0], q[1], q[2], q[3]}; *(f32x4*)(Qf + tt * 128 + k0 + 4) = (f32x4){q[4], q[5], q[6], q[7]};
        *(f32x4*)(Kf + tt * 128 + k0) = (f32x4){kk[0], kk[1], kk[2], kk[3]}; *(f32x4*)(Kf + tt * 128 + k0 + 4) = (f32x4){kk[4], kk[5], kk[6], kk[7]};
        if (valid) { u32x4 og; og.x = pk2(sg[0], sg[1]); og.y = pk2(sg[2], sg[3]); og.z = pk2(sg[4], sg[5]); og.w = pk2(sg[6], sg[7]); *(u32x4*)(zr + C_HG) = og; }
    }
    __syncthreads();
    if (tid < 128) { float run = 0.f;
#pragma unroll
        for (int tt = 0; tt < 32; ++tt) { run += Gf[tt * 128 + tid]; Gf[tt * 128 + tid] = run; } dec[tid] = __expf(run); }
    __syncthreads();
    for (int e = 0; e < 8; ++e) { const int idx = tid + NTH * e, tt = idx >> 7, k = idx & 127; const float lam = Gf[idx], le = Gf[31 * 128 + k], q = Qf[idx], kk = Kf[idx];
        Qh[tt * 136 + k] = f2bf(q * __expf(lam)); Kc[tt * 136 + k] = f2bf(kk * __expf(-lam)); KbT[k * 40 + tt] = f2bf(kk * __expf(le - lam)); }
    __syncthreads();
    unsigned char* side = p.ws + WS_HS + (size_t)item * HS_BYTES;
    {
        const int kt = w >> 1, s = w & 1; const bf16_t* qa = Qh + l31 * 136 + 32 * kt + 16 * s + 4 * hh;
        *(bf16x8*)hfrag(p, bl, h, ci, 0, w, lane) = ld44(qa, qa + 8);
        *(bf16x8*)hfrag(p, bl, h, ci, 1, w, lane) = *(const bf16x8*)(KbT + (32 * kt + l31) * 40 + 16 * s + 8 * hh);
        *(bf16x8*)hfrag(p, bl, h, ci, 2, w, lane) = *(const bf16x8*)(VT + (32 * kt + l31) * 40 + 16 * s + 8 * hh);
        if (tid < 128) ((float*)(side + 2048))[tid] = dec[tid];
    }
    if (w == 0) {
        f32x16 X;
#pragma unroll
        for (int r = 0; r < 16; ++r) X[r] = 0.f;
#pragma unroll
        for (int s8 = 0; s8 < 8; ++s8) X = mfma32(*(const bf16x8*)(Kc + l31 * 136 + 16 * s8 + 8 * hh), *(const bf16x8*)(Qh + l31 * 136 + 16 * s8 + 8 * hh), X);
#pragma unroll
        for (int r = 0; r < 16; ++r) { const int srow = (r & 3) + 8 * (r >> 2) + 4 * hh; attL[l31 * 40 + srow] = f2bf(srow > l31 ? 0.f : X[r]); }
        asm volatile("s_waitcnt lgkmcnt(0)" ::: "memory");
#pragma unroll
        for (int st = 0; st < 2; ++st) ((bf16x8*)side)[st * 64 + lane] = *(const bf16x8*)(attL + l31 * 40 + 16 * st + 8 * hh);
    }
    __syncthreads();
}

__device__ void hgrn_seq(const Params& p, int l, int chain, unsigned char* smem) {
    const int bl = chain >> 3, h = chain & 7, m0 = bl * LL, tid = otid(), w = tid >> 6, lane = tid & 63, l31 = lane & 31, hh = lane >> 5;
    float* Ob = (float*)smem;
    bf16_t* Z = (bf16_t*)(p.ws + WS_Z);
    const int vt = w & 3, kt0 = 2 * (w >> 2);
    f32x16 S[2];
#pragma unroll
    for (int r = 0; r < 16; ++r) { S[0][r] = 0.f; S[1][r] = 0.f; }
    bf16x8 qf[2][2], kf[2][2], vf[2], af[2]; f32x4 dv[2][4];
    const bf16_t* pq[2][2]; const bf16_t* pk[2][2]; const bf16_t* pv[2];
#pragma unroll
    for (int k2 = 0; k2 < 2; ++k2)
#pragma unroll
        for (int s = 0; s < 2; ++s) { pq[k2][s] = hfrag(p, bl, h, 0, 0, (kt0 + k2) * 2 + s, lane); pk[k2][s] = hfrag(p, bl, h, 0, 1, (kt0 + k2) * 2 + s, lane); }
#pragma unroll
    for (int s = 0; s < 2; ++s) pv[s] = hfrag(p, bl, h, 0, 2, vt * 2 + s, lane);
#define HG_LOAD(ci_) do { const unsigned char* sd_ = p.ws + WS_HS + (size_t)(chain * NCH + (ci_)) * HS_BYTES; \
        if ((ci_) < 64) { const size_t co_ = (size_t)(ci_) * 32 * ZS; \
            _Pragma("unroll") for (int k2 = 0; k2 < 2; ++k2) _Pragma("unroll") for (int s = 0; s < 2; ++s) { qf[k2][s] = *(const bf16x8*)(pq[k2][s] + co_); kf[k2][s] = *(const bf16x8*)(pk[k2][s] + co_); } \
            _Pragma("unroll") for (int s = 0; s < 2; ++s) vf[s] = *(const bf16x8*)(pv[s] + co_); \
        } else { \
            _Pragma("unroll") for (int k2 = 0; k2 < 2; ++k2) _Pragma("unroll") for (int s = 0; s < 2; ++s) { qf[k2][s] = *(const bf16x8*)hfrag(p, bl, h, 64, 0, (kt0 + k2) * 2 + s, lane); kf[k2][s] = *(const bf16x8*)hfrag(p, bl, h, 64, 1, (kt0 + k2) * 2 + s, lane); } \
            _Pragma("unroll") for (int s = 0; s < 2; ++s) vf[s] = *(const bf16x8*)hfrag(p, bl, h, 64, 2, vt * 2 + s, lane); } \
        _Pragma("unroll") for (int s = 0; s < 2; ++s) af[s] = ((const bf16x8*)sd_)[s * 64 + lane]; \
        _Pragma("unroll") for (int k2 = 0; k2 < 2; ++k2) _Pragma("unroll") for (int q = 0; q < 4; ++q) dv[k2][q] = *(const f32x4*)((const float*)(sd_ + 2048) + 32 * (kt0 + k2) + 8 * q + 4 * hh); } while (0)
    HG_LOAD(0);
    const f32x4 nw0 = *(const f32x4*)(p.hnw + l * 128 + (tid & 15) * 8), nw1 = *(const f32x4*)(p.hnw + l * 128 + (tid & 15) * 8 + 4);
    for (int ci = 0; ci < NCH; ++ci) {
        const int t0 = ci * 32;
        u32x4 gg = {0u, 0u, 0u, 0u}; { const int tg = t0 + (tid >> 4); if (tg < LL) gg = *(const u32x4*)(Z + (size_t)(m0 + tg) * ZS + h * 128 + (tid & 15) * 8 + C_HG); }
        f32x16 O;
#pragma unroll
        for (int r = 0; r < 16; ++r) O[r] = 0.f;
#pragma unroll
        for (int k2 = 0; k2 < 2; ++k2)
#pragma unroll
            for (int s = 0; s < 2; ++s) O = mfma32(qf[k2][s], pack8(S[k2], s), O);
        if (w < 4) { O = mfma32(af[0], vf[0], O); O = mfma32(af[1], vf[1], O); }
#pragma unroll
        for (int k2 = 0; k2 < 2; ++k2) {
#pragma unroll
            for (int r = 0; r < 16; ++r) S[k2][r] *= dv[k2][r >> 2][r & 3];
#pragma unroll
            for (int st = 0; st < 2; ++st) S[k2] = mfma32(kf[k2][st], vf[st], S[k2]); }
        if (ci + 1 < NCH) HG_LOAD(ci + 1);
        float* Obw = Ob + ((ci & 1) * 2 + (w >> 2)) * (32 * 132);
#pragma unroll
        for (int r = 0; r < 16; ++r) Obw[((r & 3) + 8 * (r >> 2) + 4 * hh) * 132 + 32 * vt + l31] = O[r];
        __syncthreads();
        { const int tt = tid >> 4, v0 = (tid & 15) * 8, t = t0 + tt; const float* oa = Ob + ((ci & 1) * 2) * (32 * 132) + tt * 132 + v0; const float* ob = oa + 32 * 132;
            const f32x4 a0 = *(const f32x4*)oa, a1 = *(const f32x4*)(oa + 4), b0 = *(const f32x4*)ob, b1 = *(const f32x4*)(ob + 4);
            float o[8]; float ss = 0.f;
#pragma unroll
            for (int j = 0; j < 4; ++j) { o[j] = a0[j] + b0[j]; o[4 + j] = a1[j] + b1[j]; }
#pragma unroll
            for (int j = 0; j < 8; ++j) ss += o[j] * o[j];
            ss = row16_sum(ss);
            const float rn = rsqrtf(ss * (1.0f / 128.0f) + 1e-6f);
            if (t < LL) { bf16_t* zr = Z + (size_t)(m0 + t) * ZS + h * 128 + v0;
                u32x4 ov; ov.x = pk2(o[0] * rn * nw0[0] * lo2f(gg.x), o[1] * rn * nw0[1] * hi2f(gg.x)); ov.y = pk2(o[2] * rn * nw0[2] * lo2f(gg.y), o[3] * rn * nw0[3] * hi2f(gg.y));
                ov.z = pk2(o[4] * rn * nw1[0] * lo2f(gg.z), o[5] * rn * nw1[1] * hi2f(gg.z)); ov.w = pk2(o[6] * rn * nw1[2] * lo2f(gg.w), o[7] * rn * nw1[3] * hi2f(gg.w));
                *(u32x4*)(zr + C_HQ) = ov; } }
    }
    __syncthreads();
#undef HG_LOAD
}

#define TR16(o, a) asm volatile( \
    "ds_read_b64_tr_b16 %0, %16 offset:0\n\tds_read_b64_tr_b16 %1, %16 offset:2176\n\tds_read_b64_tr_b16 %2, %16 offset:64\n\tds_read_b64_tr_b16 %3, %16 offset:2240\n\t" \
    "ds_read_b64_tr_b16 %4, %16 offset:128\n\tds_read_b64_tr_b16 %5, %16 offset:2304\n\tds_read_b64_tr_b16 %6, %16 offset:192\n\tds_read_b64_tr_b16 %7, %16 offset:2368\n\t" \
    "ds_read_b64_tr_b16 %8, %16 offset:4352\n\tds_read_b64_tr_b16 %9, %16 offset:6528\n\tds_read_b64_tr_b16 %10, %16 offset:4416\n\tds_read_b64_tr_b16 %11, %16 offset:6592\n\t" \
    "ds_read_b64_tr_b16 %12, %16 offset:4480\n\tds_read_b64_tr_b16 %13, %16 offset:6656\n\tds_read_b64_tr_b16 %14, %16 offset:4544\n\tds_read_b64_tr_b16 %15, %16 offset:6720\n\t" \
    "s_waitcnt lgkmcnt(0)" \
    : "=&v"(o[0]), "=&v"(o[1]), "=&v"(o[2]), "=&v"(o[3]), "=&v"(o[4]), "=&v"(o[5]), "=&v"(o[6]), "=&v"(o[7]), "=&v"(o[8]), "=&v"(o[9]), "=&v"(o[10]), "=&v"(o[11]), "=&v"(o[12]), "=&v"(o[13]), "=&v"(o[14]), "=&v"(o[15]) \
    : "v"(a) : "memory")

__device__ void attn_item(const Params& p, int l, int item, unsigned char* smem) {
    const int qt = 16 - item / 32, bl = (item & 31) >> 3, h = item & 7, q0 = qt * 128, m0 = bl * LL;
    const int tid = otid(), w = tid >> 6, lane = tid & 63, l31 = lane & 31, hh = lane >> 5, g2 = w >> 2, wq = w & 3;
    bf16_t* Ks = (bf16_t*)smem; bf16_t* Vs = (bf16_t*)(smem + 17408); float* Ex = (float*)(smem + 34816);
    bf16_t* Z = (bf16_t*)(p.ws + WS_Z);
    const int qrow = q0 + wq * 32 + l31, qr = qrow < LL ? qrow : LL - 1;
    const unsigned vaddr = (unsigned)(unsigned long long)(LAS unsigned char*)(smem + 17408) + (unsigned)((((4 * hh + ((lane & 15) >> 2)) * 136) + 16 * ((lane >> 4) & 1) + 4 * (lane & 3)) * 2);
    bf16x8 qf[4];
    { const bf16_t* qp = Z + (size_t)(m0 + qr) * ZS + C_AQ + h * 128 + g2 * 64 + 8 * hh;
#pragma unroll
        for (int s = 0; s < 4; ++s) qf[s] = *(const bf16x8*)(qp + 16 * s); }
    f32x16 O[4];
#pragma unroll
    for (int v = 0; v < 4; ++v)
#pragma unroll
        for (int r = 0; r < 16; ++r) O[v][r] = 0.f;
    float mrun = -1e30f, lrun = 0.f;
    int nkt = (q0 + 128 + 63) / 64; if (nkt > (LL + 63) / 64) nkt = (LL + 63) / 64;
    u32x4 kreg[2], vreg[2];
#define AT_ISSUE(kt_) do { _Pragma("unroll") for (int e = 0; e < 2; ++e) { const int idx = tid + NTH * e, key = idx >> 4, c16 = idx & 15; int kr = (kt_) * 64 + key; kr = kr < LL ? kr : LL - 1; \
        const bf16_t* zr = Z + (size_t)(m0 + kr) * ZS + h * 128 + c16 * 8; kreg[e] = *(const u32x4*)(zr + C_AK); vreg[e] = *(const u32x4*)(zr + C_AV); } } while (0)
    AT_ISSUE(0);
    for (int kt = 0; kt < nkt; ++kt) {
        const int k0 = kt * 64;
        __syncthreads();
#pragma unroll
        for (int e = 0; e < 2; ++e) { const int idx = tid + NTH * e, key = idx >> 4, c16 = idx & 15; *(u32x4*)(Ks + key * 136 + c16 * 8) = kreg[e]; *(u32x4*)(Vs + key * 136 + c16 * 8) = vreg[e]; }
        if (kt + 1 < nkt) AT_ISSUE(kt + 1);
        __syncthreads();
        f32x16 X[2];
#pragma unroll
        for (int t2 = 0; t2 < 2; ++t2) {
#pragma unroll
            for (int r = 0; r < 16; ++r) X[t2][r] = 0.f;
#pragma unroll
            for (int s = 0; s < 4; ++s) X[t2] = mfma32(*(const bf16x8*)(Ks + (32 * t2 + l31) * 136 + g2 * 64 + 16 * s + 8 * hh), qf[s], X[t2]); }
        float mx = -1e30f;
#pragma unroll
        for (int t2 = 0; t2 < 2; ++t2)
#pragma unroll
            for (int r = 0; r < 16; ++r) { const int key = k0 + 32 * t2 + (r & 3) + 8 * (r >> 2) + 4 * hh; if (key > qrow) X[t2][r] = -1e30f; mx = fmaxf(mx, X[t2][r]); }
        mx = fmaxf(mx, __shfl_xor(mx, 32));
        const float mnew = fmaxf(mrun, mx), alpha = __expf(mrun - mnew); float sm = 0.f;
#pragma unroll
        for (int t2 = 0; t2 < 2; ++t2)
#pragma unroll
            for (int r = 0; r < 16; ++r) { const float e = __expf(X[t2][r] - mnew); X[t2][r] = e; sm += e; }
        sm += __shfl_xor(sm, 32); lrun = lrun * alpha + sm; mrun = mnew;
#pragma unroll
        for (int v = 0; v < 4; ++v)
#pragma unroll
            for (int r = 0; r < 16; ++r) O[v][r] *= alpha;
#pragma unroll
        for (int t2 = 0; t2 < 2; ++t2) { u32x2 o[16]; const unsigned va = vaddr + t2 * 8704; TR16(o, va);
#pragma unroll
            for (int s = 0; s < 2; ++s) { const bf16x8 pb = pack8(X[t2], s);
#pragma unroll
                for (int v = 0; v < 4; ++v) { u32x4 fw; fw.x = o[(s * 4 + v) * 2].x; fw.y = o[(s * 4 + v) * 2].y; fw.z = o[(s * 4 + v) * 2 + 1].x; fw.w = o[(s * 4 + v) * 2 + 1].y;
                    O[v] = mfma32(__builtin_bit_cast(bf16x8, fw), pb, O[v]); } } }
    }
#undef AT_ISSUE
    const float il = 1.0f / lrun; const int ql = wq * 32 + l31;
    if (g2 == 1) {
#pragma unroll
        for (int v = 0; v < 4; ++v)
#pragma unroll
            for (int r4 = 0; r4 < 4; ++r4) { f32x4 o; o[0] = O[v][4 * r4] * il; o[1] = O[v][4 * r4 + 1] * il; o[2] = O[v][4 * r4 + 2] * il; o[3] = O[v][4 * r4 + 3] * il;
                *(f32x4*)(Ex + ql * 132 + 32 * v + 8 * r4 + 4 * hh) = o; }
    }
    __syncthreads();
    if (g2 == 0) {
        float d1 = 0.f, d2 = 0.f;
        for (int j = 0; j < 64; ++j) { d1 += p.lq1[l * 64 + j] * p.lk1[l * 64 + j]; d2 += p.lq2[l * 64 + j] * p.lk2[l * 64 + j]; }
        const float lam_init = 0.8f - 0.6f * expf(-0.3f * (float)l), lam = expf(d1) - expf(d2) + lam_init;
        float ss = 0.f;
#pragma unroll
        for (int v = 0; v < 4; ++v)
#pragma unroll
            for (int r4 = 0; r4 < 4; ++r4) { const f32x4 o2 = *(const f32x4*)(Ex + ql * 132 + 32 * v + 8 * r4 + 4 * hh);
#pragma unroll
                for (int j = 0; j < 4; ++j) { const float o = O[v][4 * r4 + j] * il - lam * o2[j]; O[v][4 * r4 + j] = o; ss += o * o; } }
        ss += __shfl_xor(ss, 32);
        const float rn = rsqrtf(ss * (1.0f / 128.0f) + 1e-6f) * (1.0f - lam_init);
        if (qrow < LL) { bf16_t* zr = Z + (size_t)(m0 + qrow) * ZS + h * 128;
            u32x2 gg[4][4]; f32x4 nwv[4][4];
#pragma unroll
            for (int v = 0; v < 4; ++v)
#pragma unroll
                for (int r4 = 0; r4 < 4; ++r4) { gg[v][r4] = *(const u32x2*)(zr + C_AG + 32 * v + 8 * r4 + 4 * hh); nwv[v][r4] = *(const f32x4*)(p.att_norm_w + l * 128 + 32 * v + 8 * r4 + 4 * hh); }
#pragma unroll
            for (int v = 0; v < 4; ++v)
#pragma unroll
                for (int r4 = 0; r4 < 4; ++r4) { const int vc = 32 * v + 8 * r4 + 4 * hh; const f32x4 nw = nwv[v][r4]; const u32x2 g = gg[v][r4];
                    u32x2 ov; ov.x = pk2(O[v][4 * r4] * rn * nw[0] * silu(lo2f(g.x)), O[v][4 * r4 + 1] * rn * nw[1] * silu(hi2f(g.x)));
                    ov.y = pk2(O[v][4 * r4 + 2] * rn * nw[2] * silu(lo2f(g.y)), O[v][4 * r4 + 3] * rn * nw[3] * silu(hi2f(g.y)));
                    *(u32x2*)(zr + C_AQ + vc) = ov; } }
    }
    __syncthreads();
}

__device__ void post_range(const Params& p, int l, int g, int m0r, int m1r, int mstep) {
    const int tid0 = otid(), wave = tid0 >> 6, lane = tid0 & 63;
    const float* T = (const float*)(p.ws + WS_T); const float* pw = p.post_w + l * DM;
    for (int m = m0r + wave; m < m1r; m += mstep) {
        const int b = g * GB + m / LL, t = m % LL;
        if (l == 1 && t < NMETA) continue;
        const float* h = h_in_row(p, l, b, t);
        float* ho = t < NMETA ? (float*)(p.ws + WS_HM) + ((size_t)b * 16 + t) * DM : p.out + ((size_t)b * SEQ + (t - NMETA)) * DM;
        f32x4 v[4]; float ss = 0.f;
#pragma unroll
        for (int i = 0; i < 4; ++i) { v[i] = *(const f32x4*)(T + (size_t)m * DM + (lane + 64 * i) * 4); ss += v[i][0] * v[i][0] + v[i][1] * v[i][1] + v[i][2] * v[i][2] + v[i][3] * v[i][3]; }
        ss = wsum(ss); const float rn = rsqrtf(ss * (1.0f / DM) + 1e-6f);
#pragma unroll
        for (int i = 0; i < 4; ++i) { const f32x4 w = *(const f32x4*)(pw + (lane + 64 * i) * 4); const f32x4 hv = *(const f32x4*)(h + (lane + 64 * i) * 4);
            f32x4 o; o[0] = hv[0] + v[i][0] * rn * w[0]; o[1] = hv[1] + v[i][1] * rn * w[1]; o[2] = hv[2] + v[i][2] * rn * w[2]; o[3] = hv[3] + v[i][3] * rn * w[3];
            *(f32x4*)(ho + (lane + 64 * i) * 4) = o; }
    }
}


__device__ void post_phase(const Params& p, int l, int g) { post_range(p, l, g, obid() * 8, MG, (int)gridDim.x * 8); }

#define XB_TMO      128
#define XB_XCNT(j)  (256  + 64 * (j))
#define XB_XSUB(j)  (1280 + 64 * (j))
#define XB_XGEN(j)  (2304 + 64 * (j))
#define XB_TOP      3328
#define XB_TOPGEN   3392
#define XCD_BAR_WORDS 3456
#define XB_SPIN_CAP (1u << 22)
__device__ __forceinline__ unsigned xb_ld(unsigned* p)              { return __hip_atomic_load(p, __ATOMIC_RELAXED, __HIP_MEMORY_SCOPE_AGENT); }
__device__ __forceinline__ unsigned xb_add(unsigned* p, unsigned v) { return __hip_atomic_fetch_add(p, v, __ATOMIC_RELAXED, __HIP_MEMORY_SCOPE_AGENT); }
__device__ __forceinline__ unsigned xb_xcc_id() { return (unsigned)__builtin_amdgcn_s_getreg((3 << 11) | 20) & 0xFu; }
#define XB_SPIN(cond, bar) do { unsigned _sp = 0; while (cond) { __builtin_amdgcn_s_sleep(1); \
    if ((++_sp & 255u) == 0u) { if (xb_ld(&(bar)[XB_TMO])) break; if (_sp > XB_SPIN_CAP) { atomicAdd(&(bar)[XB_TMO], 1u); break; } } } } while (0)
struct XcdBarrier { unsigned* bar; unsigned x; volatile LAS unsigned* st; };
__device__ __forceinline__ XcdBarrier xcd_barrier_post(unsigned* bar, volatile LAS unsigned* st) {
    XcdBarrier b; b.bar = bar; b.x = xb_xcc_id(); b.st = st;
    if (threadIdx.x == 0) (void)xb_add(&bar[XB_XCNT(b.x)], 1u);
    return b;
}
__device__ __forceinline__ void xcd_barrier_complete(unsigned* bar, unsigned x, unsigned& nloc, unsigned& nx) {
    const unsigned G = gridDim.x * gridDim.y * gridDim.z;
    unsigned sum, cnt, mine, sp = 0u;
    for (;;) {
        sum = 0u; cnt = 0u; mine = 0u;
#pragma unroll
        for (unsigned j = 0; j < 16; ++j) { const unsigned c = xb_ld(&bar[XB_XCNT(j)]); sum += c; cnt += (c > 0u) ? 1u : 0u; mine = (j == x) ? c : mine; }
        if (sum == G) break;
        __builtin_amdgcn_s_sleep(1);
        if ((++sp & 255u) == 0u) { if (xb_ld(&bar[XB_TMO])) break; if (sp > XB_SPIN_CAP) { atomicAdd(&bar[XB_TMO], 1u); break; } }
    }
    nloc = mine > 0u ? mine : 1u; nx = cnt > 0u ? cnt : 1u;
}
__device__ __forceinline__ void xcd_barrier(const XcdBarrier& b, unsigned* bar_) {
    asm volatile("s_waitcnt vmcnt(0)" ::: "memory");
    __syncthreads();
    if (threadIdx.x == 0) {
        unsigned* bar = bar_; const unsigned bx = xb_xcc_id();
        __builtin_amdgcn_s_waitcnt(0);
        unsigned nloc = b.st[0], nx = b.st[1];
        if (nloc == 0u) { xcd_barrier_complete(bar, bx, nloc, nx); b.st[0] = nloc; b.st[1] = nx; }
        const unsigned old = xb_add(&bar[XB_XSUB(bx)], 1u);
        const unsigned gen = old / nloc;
        if (old + 1u == (gen + 1u) * nloc) {
            __builtin_amdgcn_fence(__ATOMIC_RELEASE, "agent");
            asm volatile("s_waitcnt vmcnt(0)" ::: "memory");
            const unsigned og = xb_add(&bar[XB_TOP], 1u);
            const unsigned tg = og / nx;
            if (og + 1u == (tg + 1u) * nx) xb_add(&bar[XB_TOPGEN], 1u);
            else XB_SPIN(xb_ld(&bar[XB_TOPGEN]) == tg, bar);
            __builtin_amdgcn_fence(__ATOMIC_ACQUIRE, "agent");
            xb_add(&bar[XB_XGEN(bx)], 1u);
            asm volatile("s_waitcnt vmcnt(0)" ::: "memory");
        } else {
            XB_SPIN(xb_ld(&bar[XB_XGEN(bx)]) == gen, bar);
            __builtin_amdgcn_fence(__ATOMIC_ACQUIRE, "agent");
            asm volatile("s_waitcnt vmcnt(0)" ::: "memory");
        }
    }
    __syncthreads();
}

constexpr int NPH = 1 + 2 * NG * 7;
template <int s>
__device__ __forceinline__ void run_stage(const Params& p, int l, int g, unsigned char* smem) {
    bf16_t* Z = (bf16_t*)(p.ws + WS_Z);
    if (s == 0) pn_phase(p, l, g);
    else if (s == 1) { const bf16_t* U = (const bf16_t*)(p.ws + WS_U); const bf16_t* W = (const bf16_t*)(p.ws + WS_WIN) + (size_t)l * ZS * 1024; EpiZ epi{Z, 0};
        if ((gridDim.x & 7) == 0) {
            const int b = obid(), x = b & 7, j = b >> 3;
            const Enum1 en{U, W, x, j, (int)(gridDim.x >> 3)}; gemm_stream(en, epi, 1024, MG, 1024, 16, smem);
        } else for (int u = obid(); u < 33 * 61; u += gridDim.x) gemm_unit(U, 1024, MG, W, 1024, 16, (u % 33) * 256, (u / 33) * 256, smem, epi); }
    else if (s == 2) { rope_phase(p);
        unsigned* ctr = (unsigned*)(p.ws + WS_BAR) + 3520 + 64 * (l * NG + g) + 32;
        volatile LAS unsigned* nxt = (volatile LAS unsigned*)(LAS unsigned char*)(smem + LDS_MAIN + 8);
        for (;;) {
            __syncthreads();
            if (threadIdx.x == 0) *nxt = __hip_atomic_fetch_add(ctr, 1u, __ATOMIC_RELAXED, __HIP_MEMORY_SCOPE_AGENT);
            __syncthreads();
            const int it = (int)*nxt;
            if (it >= 64 * NCH / 8 + 32 * NCH) break;
            if (it < 64 * NCH / 8) { const int tid = otid(), wv = tid >> 6; rwkv_summary(p, l, it * 8 + wv, smem + wv * WLDS, tid & 63); }
            else hgrn_summary(p, l, it - 64 * NCH / 8, smem); } }
    else if (s == 3) {
        unsigned* ctr = (unsigned*)(p.ws + WS_BAR) + 3520 + 64 * (l * NG + g);
        const int lgn = l * NG + g + 1, npn = lgn < 2 * NG ? MG / 32 : 0;
        const int lgp = l * NG + g - 1, npo = lgp >= 0 ? MG / 32 : 0;
        volatile LAS unsigned* nxt = (volatile LAS unsigned*)(LAS unsigned char*)(smem + LDS_MAIN + 8);
        for (;;) {
            __syncthreads();
            if (threadIdx.x == 0) *nxt = __hip_atomic_fetch_add(ctr, 1u, __ATOMIC_RELAXED, __HIP_MEMORY_SCOPE_AGENT);
            __syncthreads();
            const int it = (int)*nxt;
            if (it >= 32 + 32 + 544 + npn + npo) break;
            if (it >= 32 + 32 + 544 + npn) { const int k = it - (32 + 32 + 544 + npn); post_range(p, lgp / NG, lgp % NG, 32 * k, 32 * k + 32, 8); continue; }
            if (it >= 32 + 32 + 544) { const int k = it - (32 + 32 + 544); pn_range(p, lgn / NG, lgn % NG, 32 * k, 32 * k + 32, 8); continue; }
            if (it < 32) { const int tid = otid(), wv = tid >> 6;
                if (wv < 4) rwkv_seq(p, l, it * 2 + (wv >> 1), wv & 1, tid & 63, (float*)smem, wv >> 1, smem + 4096 + wv * 19456);
                else { for (int ci = 0; ci < NCH; ++ci) __builtin_amdgcn_s_barrier(); }
                __syncthreads(); }
            else if (it < 64) hgrn_seq(p, l, it - 32, smem); else attn_item(p, l, it - 64, smem); } }
    else if (s == 4) { const bf16_t* Wl = (const bf16_t*)(p.ws + WS_WOUT + (size_t)l * WOUT_L);
        if ((gridDim.x & 7) == 0) { const int b = obid(), x = b & 7, j = b >> 3;
            const Enum4 en{Z, Wl, x, j, (int)(gridDim.x >> 3)}; EpiGate epi{Z, (bf16_t*)(p.ws + WS_GATED), 0}; gemm_stream(en, epi, ZS, MG, 1024, 16, smem);
        } else for (int u = obid(); u < 3 * 132; u += gridDim.x) { const int br = u / 132, r = u % 132; const int co = br == 0 ? C_AQ : br == 1 ? C_RR : C_HQ; EpiGate epi{Z, (bf16_t*)(p.ws + WS_GATED), br};
            gemm_unit(Z + co, ZS, MG, Wl + (size_t)br * 1024 * 1024, 1024, 16, (r % 33) * 256, (r / 33) * 256, smem, epi); } }
    else if (s == 5) { const bf16_t* Wl = (const bf16_t*)(p.ws + WS_WOUT + (size_t)l * WOUT_L) + 3ull * 1024 * 1024; EpiT epi{(float*)(p.ws + WS_T), 0};
        if ((gridDim.x & 7) == 0) { const int b = obid(), x = b & 7, j = b >> 3;
            const Enum5 en{(const bf16_t*)(p.ws + WS_GATED), Wl, x, j, (int)(gridDim.x >> 3)}; gemm_stream(en, epi, 3072, MG, 3072, 48, smem);
        } else for (int u = obid(); u < 132; u += gridDim.x) gemm_unit((const bf16_t*)(p.ws + WS_GATED), 3072, MG, Wl, 3072, 48, (u % 33) * 256, (u / 33) * 256, smem, epi); }
    else post_phase(p, l, g);
}

__device__ __forceinline__ void interval_a(const Params& p, int lg, unsigned char* smem) {
    const int b = obid(), x = b & 7, j = b >> 3, nj = (int)(gridDim.x >> 3);
    if (lg > 0) { const int lp = (lg - 1) / NG; const bf16_t* Wl = (const bf16_t*)(p.ws + WS_WOUT + (size_t)lp * WOUT_L) + 3ull * 1024 * 1024; EpiT epi{(float*)(p.ws + WS_T), 0};
        const Enum5 en{(const bf16_t*)(p.ws + WS_GATED), Wl, x, j, nj}; gemm_stream(en, epi, 3072, MG, 3072, 48, smem); }
    if (lg < 2 * NG) { const int l = lg / NG; const bf16_t* U = (const bf16_t*)(p.ws + WS_U); const bf16_t* W = (const bf16_t*)(p.ws + WS_WIN) + (size_t)l * ZS * 1024; EpiZ epi{(bf16_t*)(p.ws + WS_Z), 0};
        const Enum1m en{U, W, x, j, nj, (lg > 0 && gridDim.x == 256) ? 1 : 0}; gemm_stream(en, epi, 1024, MG, 1024, 16, smem); }
}

template <int s>
__global__ void __launch_bounds__(NTH, 2) stage_k(Params p, int l, int g) {
    extern __shared__ __attribute__((aligned(16))) unsigned char smem[];
    run_stage<s>(p, l, g, smem);
}
__global__ void __launch_bounds__(NTH, 2) p0_k(Params p) {
    extern __shared__ __attribute__((aligned(16))) unsigned char smem[];
    for (int it = obid(); it < 2 * P0_PER_LAYER + 64; it += gridDim.x) p0_item(p, it, (float*)smem);
}


#if ONE_LAUNCH
__global__ void __launch_bounds__(NTH, 2) mega(Params p) {
    extern __shared__ __attribute__((aligned(16))) unsigned char smem[];
    cg::grid_group grid = cg::this_grid();
    volatile LAS unsigned* st = (volatile LAS unsigned*)(LAS unsigned char*)(smem + LDS_MAIN);
    if (threadIdx.x == 0) { st[0] = 0u; st[1] = 0u; }
    __syncthreads();
    const XcdBarrier xb = xcd_barrier_post((unsigned*)(p.ws + WS_BAR), st);
    for (int it = blockIdx.x; it < 2 * P0_PER_LAYER + 64; it += gridDim.x) { if (gridDim.x == 256 && ((it >= P0_PER_LAYER && it < 2 * P0_PER_LAYER) || it >= 2 * P0_PER_LAYER + 32)) continue; p0_item(p, it, (float*)smem); }
    grid.sync();
    { Params q = p; asm volatile("" : "+s"(q.ws)); run_stage<0>(q, 0, 0, smem); xcd_barrier(xb, (unsigned*)(q.ws + WS_BAR)); }
    for (int lg = 0; lg < 2 * NG; ++lg) {
        const int l = lg / NG, g = lg % NG;
        Params q = p; asm volatile("" : "+s"(q.ws));
        interval_a(q, lg, smem); xcd_barrier(xb, (unsigned*)(q.ws + WS_BAR));
        run_stage<2>(q, l, g, smem); xcd_barrier(xb, (unsigned*)(q.ws + WS_BAR));
        run_stage<3>(q, l, g, smem); xcd_barrier(xb, (unsigned*)(q.ws + WS_BAR));
        run_stage<4>(q, l, g, smem);
        if (gridDim.x == 256 && lg < NG) { const int b = blockIdx.x, j = b >> 3, x = b & 7;
            if (j >= 18) for (int k = (j - 18) * 8 + x; k < 1240; k += 112) { const int idx = lg * 1240 + k; p0_item(p, idx < P0_PER_LAYER ? P0_PER_LAYER + idx : 2 * P0_PER_LAYER + 32 + (idx - P0_PER_LAYER), (float*)smem); } }
        xcd_barrier(xb, (unsigned*)(q.ws + WS_BAR));
    }
    { Params q = p; asm volatile("" : "+s"(q.ws)); interval_a(q, 2 * NG, smem); xcd_barrier(xb, (unsigned*)(q.ws + WS_BAR)); run_stage<6>(q, 1, NG - 1, smem); }
}
#endif

template <int s> static void launch_stage(const Params& p, int l, int g, int grid, hipStream_t stream) {
    static bool attr = false;
    if (!attr) { (void)hipFuncSetAttribute((const void*)stage_k<s>, hipFuncAttributeMaxDynamicSharedMemorySize, LDS_BYTES); attr = true; }
    hipLaunchKernelGGL(stage_k<s>, dim3(grid), dim3(NTH), LDS_BYTES, stream, p, l, g);
}

extern "C" void kernel_launch(void* const* d_in, const int* in_sizes, int n_in, void* d_out, int out_size, void* d_ws, size_t ws_size, hipStream_t stream) {
    static int grid = 0;
    if (grid == 0) {
        if (ws_size < WS_END) { fprintf(stderr, "kernel_launch: workspace too small: %zu < %zu\n", ws_size, (size_t)WS_END); grid = -1; return; }
        int dev = 0, cus = 0;
        (void)hipGetDevice(&dev); (void)hipDeviceGetAttribute(&cus, hipDeviceAttributeMultiprocessorCount, dev);
        (void)hipFuncSetAttribute((const void*)p0_k, hipFuncAttributeMaxDynamicSharedMemorySize, LDS_BYTES);
        grid = cus > 0 ? cus : 256;
        (void)hipGetLastError();
    }
    if (grid < 0) return;
    Params p{};
    p.x = (const float*)d_in[0]; p.meta = (const float*)d_in[1]; p.pre_w = (const float*)d_in[2]; p.post_w = (const float*)d_in[3]; p.w_in = (const float*)d_in[4];
    p.lq1 = (const float*)d_in[5]; p.lk1 = (const float*)d_in[6]; p.lq2 = (const float*)d_in[7]; p.lk2 = (const float*)d_in[8]; p.att_norm_w = (const float*)d_in[9];
    p.mu = (const float*)d_in[10]; p.w0 = (const float*)d_in[11]; p.w_up = (const float*)d_in[12]; p.a0 = (const float*)d_in[13]; p.a_up = (const float*)d_in[14];
    p.k_k = (const float*)d_in[15]; p.k_a = (const float*)d_in[16]; p.r_k = (const float*)d_in[17]; p.gn_w = (const float*)d_in[18]; p.gn_b = (const float*)d_in[19];
    p.hlb = (const float*)d_in[20]; p.hnw = (const float*)d_in[21]; p.w_att_out = (const float*)d_in[22]; p.w_rwkv_out = (const float*)d_in[23]; p.w_hgrn_out = (const float*)d_in[24]; p.w_o = (const float*)d_in[25];
    p.out = (float*)d_out; p.ws = (unsigned char*)d_ws;
#if ONE_LAUNCH
    { static bool attr = false; if (!attr) { (void)hipFuncSetAttribute((const void*)mega, hipFuncAttributeMaxDynamicSharedMemorySize, LDS_BYTES); attr = true; }
      (void)hipMemsetAsync((unsigned char*)d_ws + WS_BAR, 0, 16384, stream);
      void* args[] = {&p};
      hipError_t e = hipLaunchCooperativeKernel((const void*)mega, dim3(grid), dim3(NTH), args, LDS_BYTES, stream);
      if (e != hipSuccess) fprintf(stderr, "cooperative launch failed: %s (grid %d)\n", hipGetErrorString(e), grid); }
#else
    hipLaunchKernelGGL(p0_k, dim3(grid), dim3(NTH), LDS_BYTES, stream, p);
    for (int l = 0; l < 2; ++l)
        for (int g = 0; g < NG; ++g) {
            launch_stage<0>(p, l, g, grid, stream); launch_stage<1>(p, l, g, grid, stream); launch_stage<2>(p, l, g, grid, stream); launch_stage<3>(p, l, g, grid, stream);
            launch_stage<4>(p, l, g, grid, stream); launch_stage<5>(p, l, g, grid, stream); launch_stage<6>(p, l, g, grid, stream);
        }
#endif
}
```

```cpp
#include <hip/hip_runtime.h>
#include <hip/hip_cooperative_groups.h>
#include <cstdio>
namespace cg = cooperative_groups;

typedef unsigned short bf16_t;
typedef short bf16x8 __attribute__((ext_vector_type(8)));
typedef short bf16x4 __attribute__((ext_vector_type(4)));
typedef float f32x4 __attribute__((ext_vector_type(4)));
typedef float f32x16 __attribute__((ext_vector_type(16)));
typedef unsigned u32x2 __attribute__((ext_vector_type(2)));
typedef unsigned u32x4 __attribute__((ext_vector_type(4)));

#ifndef ONE_LAUNCH
#define ONE_LAUNCH 1
#endif

constexpr int DM = 1024, NB = 16, SEQ = 2048, NMETA = 16, LL = 2064, INW = 15488, ZS = 15616;
constexpr int GB = 4, NG = 4, MG = GB * LL;
constexpr int NTH = 512;
constexpr int LDS_MAIN = 159744, LDS_BYTES = LDS_MAIN + 16;
constexpr int C_AQ = 0, C_AK = 1024, C_AV = 2048, C_AG = 3072, C_RR = 4096, C_RK = 5120, C_RV = 6144, C_RG = 7168,
              C_RWD = 8192, C_RAD = 8256, C_HQ = 8320, C_HF = 9344, C_HI = 10368, C_HG = 11392, C_MG = 12416;
constexpr size_t WS_WIN = 0;
constexpr size_t WS_WOUT = WS_WIN + 2ull * ZS * 1024 * 2;
constexpr size_t WOUT_L = 6ull * 1024 * 1024 * 2;
constexpr size_t WS_Z = WS_WOUT + 2 * WOUT_L;
constexpr size_t WS_U = WS_Z + (size_t)MG * ZS * 2;
constexpr size_t WS_P = WS_U + (size_t)MG * 1024 * 2;
constexpr size_t P_ARR = (size_t)MG * 1024 * 2;
constexpr size_t WS_PW = WS_P + 5 * P_ARR;
constexpr size_t WS_PS = WS_PW + (size_t)MG * 1024 * 4;
constexpr size_t WS_HM = WS_PS + (size_t)MG * 16 * 4 * 4;
constexpr size_t WS_LR = WS_HM + 16ull * 16 * 1024 * 4;
constexpr size_t WS_BAR = WS_LR + 4ull * 65536 * 2;
constexpr size_t WS_T = WS_BAR + 16384;
constexpr size_t WS_END = WS_T + (size_t)MG * 1024 * 4;
constexpr size_t WS_GATED = WS_P;
static_assert(WS_GATED + (size_t)MG * 3072 * 2 <= WS_PS, "alias overflow");

struct Params {
    const float* x; const float* meta; const float* pre_w; const float* post_w; const float* w_in;
    const float* lq1; const float* lk1; const float* lq2; const float* lk2; const float* att_norm_w;
    const float* mu; const float* w0; const float* w_up; const float* a0; const float* a_up; const float* k_k; const float* k_a; const float* r_k;
    const float* gn_w; const float* gn_b; const float* hlb; const float* hnw;
    const float* w_att_out; const float* w_rwkv_out; const float* w_hgrn_out; const float* w_o;
    float* out; unsigned char* ws;
};


__device__ __forceinline__ float bf2f(bf16_t h) { return __uint_as_float(((unsigned)h) << 16); }
__device__ __forceinline__ unsigned pk2(float lo, float hi) { unsigned r; asm("v_cvt_pk_bf16_f32 %0, %1, %2" : "=v"(r) : "v"(lo), "v"(hi)); return r; }
__device__ __forceinline__ void mfma_settle(f32x16& x) { asm volatile("s_nop 15\n\ts_nop 3" : "+v"(x)); }
__device__ __forceinline__ bf16_t f2bf(float f) { const __bf16 b = (__bf16)f; return __builtin_bit_cast(unsigned short, b); }
__device__ __forceinline__ float lo2f(unsigned u) { return __uint_as_float(u << 16); }
__device__ __forceinline__ float hi2f(unsigned u) { return __uint_as_float(u & 0xffff0000u); }
__device__ __forceinline__ float sigm(float x) { return __builtin_amdgcn_rcpf(1.0f + __expf(-x)); }
__device__ __forceinline__ float silu(float x) { return x * __builtin_amdgcn_rcpf(1.0f + __expf(-x)); }
__device__ __forceinline__ float tanh_fast(float x) { return 1.0f - 2.0f * __builtin_amdgcn_rcpf(1.0f + __expf(2.0f * x)); }
template <int CTRL> __device__ __forceinline__ float dpp_f(float v) { return __builtin_bit_cast(float, __builtin_amdgcn_update_dpp(0, __builtin_bit_cast(int, v), CTRL, 0xF, 0xF, false)); }
__device__ __forceinline__ float row16_sum(float v) { v += dpp_f<0xB1>(v); v += dpp_f<0x4E>(v); v += dpp_f<0x141>(v); v += dpp_f<0x140>(v); return v; }
template <int M> __device__ __forceinline__ float xor_lane(float v) {
    if (M == 1) return dpp_f<0xB1>(v);
    if (M == 2) return dpp_f<0x4E>(v);
    if (M == 8) return dpp_f<0x128>(v);
    if (M == 4) { const int s = __builtin_bit_cast(int, v); int r = __builtin_amdgcn_update_dpp(0, s, 0x104, 0xF, 0x5, false); r = __builtin_amdgcn_update_dpp(r, s, 0x114, 0xF, 0xA, false); return __builtin_bit_cast(float, r); }
    if (M == 16) {
        const unsigned u = __builtin_bit_cast(unsigned, v);
        const auto sw = __builtin_amdgcn_permlane16_swap(u, u, false, false);
        const bool odd = (__lane_id() & 16) != 0;
        return __builtin_bit_cast(float, odd ? sw[0] : sw[1]); }
    return __shfl_xor(v, M);
}
__device__ __forceinline__ float wsum(float v) {
#pragma unroll
    for (int o = 1; o < 64; o <<= 1) v += __shfl_xor(v, o);
    return v;
}
__device__ __forceinline__ f32x16 mfma32(bf16x8 a, bf16x8 b, f32x16 c) { return __builtin_amdgcn_mfma_f32_32x32x16_bf16(a, b, c, 0, 0, 0); }
__device__ __forceinline__ bf16x8 pack8(const f32x16& x, int s) {
    u32x4 w; w.x = pk2(x[8 * s + 0], x[8 * s + 1]); w.y = pk2(x[8 * s + 2], x[8 * s + 3]); w.z = pk2(x[8 * s + 4], x[8 * s + 5]); w.w = pk2(x[8 * s + 6], x[8 * s + 7]);
    return __builtin_bit_cast(bf16x8, w);
}
__device__ __forceinline__ bf16x8 ld44(const bf16_t* p0, const bf16_t* p1) {
    u32x2 a = *(const u32x2*)p0, b = *(const u32x2*)p1; u32x4 w; w.x = a.x; w.y = a.y; w.z = b.x; w.w = b.y; return __builtin_bit_cast(bf16x8, w);
}

__device__ __forceinline__ int otid() { int t = threadIdx.x; asm volatile("" : "+v"(t)); return t; }
__device__ __forceinline__ int obid() { int b = blockIdx.x; asm volatile("" : "+s"(b)); return b; }
__device__ __forceinline__ const float* h_in_row(const Params& p, int l, int b, int t) {
    if (l == 0) return t < NMETA ? p.meta + (size_t)t * DM : p.x + ((size_t)b * SEQ + (t - NMETA)) * DM;
    return t < NMETA ? (const float*)(p.ws + WS_HM) + ((size_t)b * 16 + t) * DM : p.out + ((size_t)b * SEQ + (t - NMETA)) * DM;
}

constexpr int P0_IN_TILES = 16 * 244, P0_PER_LAYER = P0_IN_TILES + 4 * 256;
__device__ void p0_item(const Params& p, int item, float* lds) {
    int l = item / P0_PER_LAYER; int r = item % P0_PER_LAYER;
    const float* src; bf16_t* dst; int Nsrc, ldd, copies, kt, nt;
    if (item >= 2 * P0_PER_LAYER) { const int x = item - 2 * P0_PER_LAYER; l = x >> 5; const int mtx = (x >> 4) & 1; nt = x & 15; kt = 0; Nsrc = 1024; copies = 1; ldd = 64;
        src = (mtx ? p.a_up : p.w_up) + (size_t)l * 65536; dst = (bf16_t*)(p.ws + WS_LR) + (size_t)(l * 2 + mtx) * 65536; }
    else if (r < P0_IN_TILES) { src = p.w_in + (size_t)l * 1024 * INW; Nsrc = INW; dst = (bf16_t*)(p.ws + WS_WIN) + (size_t)l * ZS * 1024; ldd = 1024; copies = 1; kt = r / 244; nt = r % 244; }
    else { r -= P0_IN_TILES; const int mtx = r >> 8; r &= 255; kt = r >> 4; nt = r & 15; Nsrc = 1024;
        const float* s0 = mtx == 0 ? p.w_att_out : mtx == 1 ? p.w_rwkv_out : mtx == 2 ? p.w_hgrn_out : p.w_o; src = s0 + (size_t)l * 1024 * 1024;
        bf16_t* wl = (bf16_t*)(p.ws + WS_WOUT + (size_t)l * WOUT_L);
        if (mtx < 3) { dst = wl + (size_t)mtx * 1024 * 1024; ldd = 1024; copies = 1; } else { dst = wl + 3ull * 1024 * 1024; ldd = 3072; copies = 3; } }
    const int tid0 = otid();
    for (int idx = tid0; idx < 4096; idx += NTH) { const int kk = idx >> 6, nn = idx & 63, n = nt * 64 + nn;
        lds[nn * 65 + kk] = n < Nsrc ? src[(size_t)(kt * 64 + kk) * Nsrc + n] : 0.f; }
    __syncthreads();
    const bool permw = item < 2 * P0_PER_LAYER;
    for (int idx = tid0; idx < 4096; idx += NTH) { const int nn = idx >> 6, kk = idx & 63; const bf16_t v = f2bf(lds[nn * 65 + kk]);
        const int c5 = nn & 31, nrow = permw ? (nn & 32) + 16 * ((c5 >> 2) & 1) + 4 * (c5 >> 3) + (c5 & 3) : nn;
        for (int c = 0; c < copies; ++c) dst[(size_t)(nt * 64 + nrow) * ldd + c * 1024 + kt * 64 + kk] = v; }
    __syncthreads();
}

__device__ void pn_range(const Params& p, int l, int g, int m0r, int m1r, int mstep) {
    const int tid0 = otid(), wave = tid0 >> 6, lane = tid0 & 63;
    bf16_t* U = (bf16_t*)(p.ws + WS_U); const float* pw = p.pre_w + l * DM;
    for (int m = m0r + wave; m < m1r; m += mstep) {
        const int b = g * GB + m / LL, t = m % LL; const float* h = h_in_row(p, l, b, t);
        f32x4 v[4]; float ss = 0.f;
#pragma unroll
        for (int i = 0; i < 4; ++i) { v[i] = *(const f32x4*)(h + (lane + 64 * i) * 4); ss += v[i][0] * v[i][0] + v[i][1] * v[i][1] + v[i][2] * v[i][2] + v[i][3] * v[i][3]; }
        ss = wsum(ss); const float rn = rsqrtf(ss * (1.0f / DM) + 1e-6f);
#pragma unroll
        for (int i = 0; i < 4; ++i) { const f32x4 w = *(const f32x4*)(pw + (lane + 64 * i) * 4); u32x2 o; o.x = pk2(v[i][0] * rn * w[0], v[i][1] * rn * w[1]); o.y = pk2(v[i][2] * rn * w[2], v[i][3] * rn * w[3]);
            *(u32x2*)(U + (size_t)m * DM + (lane + 64 * i) * 4) = o; }
    }
}

__device__ void pn_phase(const Params& p, int l, int g) { pn_range(p, l, g, obid() * 8, MG, (int)gridDim.x * 8); }

constexpr int BK = 64, HALF = 128, HT = HALF * BK;
__device__ __forceinline__ int lds_byte(int r, int c) { int st = (r >> 4) * 2 + (c >> 5), rr = r & 15, cc = c & 31, ob = rr * 64 + cc * 2; return st * 1024 + (ob ^ (((ob >> 9) & 1) << 5)); }
__device__ __forceinline__ void stage_rc(int b, int& R, int& C) { int st = b / 1024, sb = b % 1024, swz = sb ^ (((sb >> 9) & 1) << 5); R = (st >> 1) * 16 + swz / 64; C = (st & 1) * 32 + (swz % 64) / 2; }

#define LAS __attribute__((address_space(3)))
template <class Epi>
__device__ __forceinline__ void gemm_unit(const bf16_t* A, int lda, int M, const bf16_t* Bt, int ldb, int nt, int brow, int bcol, unsigned char* shm_, const Epi& epi) {
    LAS unsigned char* lds = (LAS unsigned char*)shm_;
    const int tid = otid(), wid = __builtin_amdgcn_readfirstlane(tid >> 6), lane = tid & 63, wr = wid >> 2, wc = wid & 3, fr = lane & 15, fq = lane >> 4;
    unsigned voffA[2], voffB[2];
#pragma unroll
    for (int i = 0; i < 2; ++i) { int R, C; stage_rc(tid * 16 + i * 8192, R, C); voffA[i] = (unsigned)(R * lda + C) * 2u; voffB[i] = (unsigned)(R * ldb + C) * 2u; }
    const size_t kstep = (size_t)(BK * 2), hA = (size_t)HALF * lda * 2, hB = (size_t)HALF * ldb * 2;
    const unsigned ldsw = (unsigned)wid * 1024u;
    const int aoff = lds_byte(wr * 64 + fr, fq * 8), boff = lds_byte(wc * 32 + fr, fq * 8);
    const char* cA = (const char*)(A + (size_t)brow * lda); const char* cB = (const char*)(Bt + (size_t)bcol * ldb);
#define SA(b, h) (((b) * 2 + (h)) * (HT * 2))
#define SB(b, h) ((4 + (b) * 2 + (h)) * (HT * 2))
#define STAGE(bufoff, gbase, voff) do { _Pragma("unroll") for (int _i = 0; _i < 2; ++_i) \
        __builtin_amdgcn_global_load_lds((const unsigned*)((const char*)(gbase) + (voff)[_i]), (LAS unsigned*)(lds + (bufoff) + ldsw + _i * 8192), 16, 0, 0); } while (0)
#define LDA(dst, b, h) do { _Pragma("unroll") for (int m = 0; m < 4; ++m) _Pragma("unroll") for (int k = 0; k < 2; ++k) dst[m][k] = *(const LAS bf16x8*)(lds + SA(b, h) + aoff + m * 2048 + k * 1024); } while (0)
#define LDB(dst, b, h) do { _Pragma("unroll") for (int n = 0; n < 2; ++n) _Pragma("unroll") for (int k = 0; k < 2; ++k) dst[n][k] = *(const LAS bf16x8*)(lds + SB(b, h) + boff + n * 2048 + k * 1024); } while (0)
#define MMA(ai, bj, At_, Bt_) do { __builtin_amdgcn_s_setprio(1); _Pragma("unroll") for (int m = 0; m < 4; ++m) _Pragma("unroll") for (int n = 0; n < 2; ++n) _Pragma("unroll") for (int k = 0; k < 2; ++k) \
      acc[ai][bj][m][n] = __builtin_amdgcn_mfma_f32_16x16x32_bf16(Bt_[n][k], At_[m][k], acc[ai][bj][m][n], 0, 0, 0); \
    __builtin_amdgcn_s_setprio(0); } while (0)
#define WAIT_V(n) asm volatile("s_waitcnt vmcnt(" #n ")" ::: "memory")
#define WAIT_L(n) asm volatile("s_waitcnt lgkmcnt(" #n ")" ::: "memory")
#define BAR __builtin_amdgcn_s_barrier()
#define SCHED __builtin_amdgcn_sched_barrier(0)
    f32x4 acc[2][2][4][2];
#pragma unroll
    for (int a = 0; a < 2; ++a)
#pragma unroll
        for (int b = 0; b < 2; ++b)
#pragma unroll
            for (int m = 0; m < 4; ++m)
#pragma unroll
                for (int n = 0; n < 2; ++n) acc[a][b][m][n] = (f32x4){0.f, 0.f, 0.f, 0.f};
    bf16x8 At[4][2], B0[2][2], B1[2][2];
    STAGE(SB(0, 0), cB, voffB); STAGE(SA(0, 0), cA, voffA); STAGE(SB(0, 1), cB + hB, voffB); STAGE(SA(0, 1), cA + hA, voffA);
    if (wr == 1) BAR;
    WAIT_V(4); BAR;
    STAGE(SB(1, 0), cB + kstep, voffB); STAGE(SA(1, 0), cA + kstep, voffA); STAGE(SB(1, 1), cB + hB + kstep, voffB);
    WAIT_V(6); BAR;
    for (int t = 0; t < nt - 2; t += 2) {
        const char* a1 = cA + (size_t)(t + 1) * kstep; const char* a2 = a1 + kstep; const char* b2 = cB + (size_t)(t + 2) * kstep; const char* a3 = a2 + kstep; const char* b3 = b2 + kstep;
        LDB(B0, 0, 0); SCHED; LDA(At, 0, 0); STAGE(SA(1, 1), a1 + hA, voffA);
        WAIT_L(8); BAR; WAIT_L(0); MMA(0, 0, At, B0); BAR; SCHED;
        LDB(B1, 0, 1); STAGE(SB(0, 0), b2, voffB);
        BAR; WAIT_L(0); MMA(0, 1, At, B1); BAR;
        LDA(At, 0, 1); STAGE(SA(0, 0), a2, voffA);
        BAR; WAIT_L(0); MMA(1, 0, At, B0); BAR; SCHED;
        STAGE(SB(0, 1), b2 + hB, voffB);
        WAIT_V(6); BAR; MMA(1, 1, At, B1); BAR;
        LDB(B0, 1, 0); SCHED; LDA(At, 1, 0); STAGE(SA(0, 1), a2 + hA, voffA);
        WAIT_L(8); BAR; WAIT_L(0); MMA(0, 0, At, B0); BAR; SCHED;
        LDB(B1, 1, 1); STAGE(SB(1, 0), b3, voffB);
        BAR; WAIT_L(0); MMA(0, 1, At, B1); BAR;
        LDA(At, 1, 1); STAGE(SA(1, 0), a3, voffA);
        BAR; WAIT_L(0); MMA(1, 0, At, B0); BAR; SCHED;
        STAGE(SB(1, 1), b3 + hB, voffB);
        WAIT_V(6); BAR; MMA(1, 1, At, B1); BAR;
    }
    { LDB(B0, 0, 0); LDA(At, 0, 0); STAGE(SA(1, 1), cA + (size_t)(nt - 1) * kstep + hA, voffA);
      BAR; WAIT_L(0); MMA(0, 0, At, B0); BAR;
      LDB(B1, 0, 1); BAR; WAIT_L(0); MMA(0, 1, At, B1); BAR;
      LDA(At, 0, 1); WAIT_V(4); BAR; WAIT_L(0); MMA(1, 0, At, B0); MMA(1, 1, At, B1); BAR; }
    { LDB(B0, 1, 0); LDA(At, 1, 0); WAIT_V(2); BAR; WAIT_L(0); MMA(0, 0, At, B0); BAR;
      LDB(B1, 1, 1); WAIT_V(0); BAR; WAIT_L(0); MMA(0, 1, At, B1); BAR;
      LDA(At, 1, 1); BAR; WAIT_L(0); MMA(1, 0, At, B0); MMA(1, 1, At, B1); BAR; }
    if (wr == 0) BAR;
#pragma unroll
    for (int ai = 0; ai < 2; ++ai)
#pragma unroll
        for (int m = 0; m < 4; ++m) { const int row = brow + ai * HALF + wr * 64 + m * 16 + fr;
            if (row < M) {
#pragma unroll
                for (int bj = 0; bj < 2; ++bj) epi(row, bcol + bj * HALF + wc * 32 + fq * 8, acc[ai][bj][m][0], acc[ai][bj][m][1], epi.pre(row, bcol + bj * HALF + wc * 32 + fq * 8)); } }
    __syncthreads();
#undef SA
#undef SB
#undef STAGE
}

struct EpiZ { typedef int Pre; bf16_t* Z; int br;
    __device__ __forceinline__ Pre pre(int, int) const { return 0; }
    __device__ __forceinline__ void operator()(int row, int col, const f32x4& v0, const f32x4& v1, Pre = 0) const { u32x4 o; o.x = pk2(v0[0], v0[1]); o.y = pk2(v0[2], v0[3]); o.z = pk2(v1[0], v1[1]); o.w = pk2(v1[2], v1[3]); *(u32x4*)(Z + (size_t)row * ZS + col) = o; } };
struct EpiGate { typedef u32x4 Pre; const bf16_t* Z; bf16_t* Gd; int br;
    __device__ __forceinline__ Pre pre(int row, int col) const { return *(const u32x4*)(Z + (size_t)row * ZS + C_MG + br * 1024 + col); }
    __device__ __forceinline__ void operator()(int row, int col, const f32x4& v0, const f32x4& v1, Pre g) const { u32x4 o;
        o.x = pk2(v0[0] * sigm(lo2f(g.x)), v0[1] * sigm(hi2f(g.x))); o.y = pk2(v0[2] * sigm(lo2f(g.y)), v0[3] * sigm(hi2f(g.y)));
        o.z = pk2(v1[0] * sigm(lo2f(g.z)), v1[1] * sigm(hi2f(g.z))); o.w = pk2(v1[2] * sigm(lo2f(g.w)), v1[3] * sigm(hi2f(g.w)));
        *(u32x4*)(Gd + (size_t)row * 3072 + br * 1024 + col) = o; } };
struct EpiT { typedef int Pre; float* T; int br;
    __device__ __forceinline__ Pre pre(int, int) const { return 0; }
    __device__ __forceinline__ void operator()(int row, int col, const f32x4& v0, const f32x4& v1, Pre = 0) const { *(f32x4*)(T + (size_t)row * DM + col) = v0; *(f32x4*)(T + (size_t)row * DM + col + 4) = v1; } };

struct UnitDesc { const bf16_t* A; const bf16_t* Bt; int brow, bcol, br; };
template <class Enum, class Epi>
__device__ __forceinline__ void gemm_stream(const Enum& en, Epi epi, int lda, int M, int ldb, int nt, unsigned char* shm_) {
    LAS unsigned char* lds = (LAS unsigned char*)shm_;
    const int tid = otid(), wid = __builtin_amdgcn_readfirstlane(tid >> 6), lane = tid & 63, wr = wid >> 2, wc = wid & 3, fr = lane & 15, fq = lane >> 4;
    UnitDesc cur, nxt; int ui = 0;
    if (!en.get(0, cur)) return;
    unsigned voffA[2], voffB[2];
#pragma unroll
    for (int i = 0; i < 2; ++i) { int R, C; stage_rc(tid * 16 + i * 8192, R, C); voffA[i] = (unsigned)(R * lda + C) * 2u; voffB[i] = (unsigned)(R * ldb + C) * 2u; }
    const size_t kstep = (size_t)(BK * 2), hA = (size_t)HALF * lda * 2, hB = (size_t)HALF * ldb * 2;
    const unsigned ldsw = (unsigned)wid * 1024u;
    const int aoff = lds_byte(wr * 64 + fr, fq * 8), boff = lds_byte(wc * 32 + fr, fq * 8);
#define SA(b, h) (((b) * 2 + (h)) * (HT * 2))
#define SB(b, h) ((4 + (b) * 2 + (h)) * (HT * 2))
#define STAGE(bufoff, gbase, voff) do { _Pragma("unroll") for (int _i = 0; _i < 2; ++_i) \
        __builtin_amdgcn_global_load_lds((const unsigned*)((const char*)(gbase) + (voff)[_i]), (LAS unsigned*)(lds + (bufoff) + ldsw + _i * 8192), 16, 0, 0); } while (0)
    f32x4 acc[2][2][4][2];
#pragma unroll
    for (int a = 0; a < 2; ++a)
#pragma unroll
        for (int b = 0; b < 2; ++b)
#pragma unroll
            for (int m = 0; m < 4; ++m)
#pragma unroll
                for (int n = 0; n < 2; ++n) acc[a][b][m][n] = (f32x4){0.f, 0.f, 0.f, 0.f};
    bf16x8 At[4][2], B0[2][2], B1[2][2];
    const char* cA = (const char*)(cur.A + (size_t)cur.brow * lda); const char* cB = (const char*)(cur.Bt + (size_t)cur.bcol * ldb);
    STAGE(SB(0, 0), cB, voffB); STAGE(SA(0, 0), cA, voffA); STAGE(SB(0, 1), cB + hB, voffB); STAGE(SA(0, 1), cA + hA, voffA);
    if (wr == 1) BAR;
    WAIT_V(4); BAR;
    STAGE(SB(1, 0), cB + kstep, voffB); STAGE(SA(1, 0), cA + kstep, voffA); STAGE(SB(1, 1), cB + hB + kstep, voffB);
    WAIT_V(6); BAR;
    for (;;) {
        const bool has_next = en.get(ui + 1, nxt);
        const char* nA = has_next ? (const char*)(nxt.A + (size_t)nxt.brow * lda) : cA; const char* nB = has_next ? (const char*)(nxt.Bt + (size_t)nxt.bcol * ldb) : cB;
        for (int t = 0; t < nt; t += 2) {
            const bool last = (t == nt - 2);
            const char* a1 = cA + (size_t)(t + 1) * kstep;
            const char* a2 = last ? nA : cA + (size_t)(t + 2) * kstep; const char* b2 = last ? nB : cB + (size_t)(t + 2) * kstep;
            const char* a3 = a2 + kstep; const char* b3 = b2 + kstep;
            LDB(B0, 0, 0); SCHED; LDA(At, 0, 0); STAGE(SA(1, 1), a1 + hA, voffA);
            WAIT_L(8); BAR; WAIT_L(0); MMA(0, 0, At, B0); BAR; SCHED;
            LDB(B1, 0, 1); STAGE(SB(0, 0), b2, voffB);
            BAR; WAIT_L(0); MMA(0, 1, At, B1); BAR;
            LDA(At, 0, 1); STAGE(SA(0, 0), a2, voffA);
            BAR; WAIT_L(0); MMA(1, 0, At, B0); BAR; SCHED;
            STAGE(SB(0, 1), b2 + hB, voffB);
            WAIT_V(6); BAR; MMA(1, 1, At, B1); BAR;
            LDB(B0, 1, 0); SCHED; LDA(At, 1, 0); STAGE(SA(0, 1), a2 + hA, voffA);
            WAIT_L(8); BAR; WAIT_L(0); MMA(0, 0, At, B0); BAR; SCHED;
            LDB(B1, 1, 1); STAGE(SB(1, 0), b3, voffB);
            BAR; WAIT_L(0); MMA(0, 1, At, B1); BAR;
            LDA(At, 1, 1); STAGE(SA(1, 0), a3, voffA);
            BAR; WAIT_L(0); MMA(1, 0, At, B0); BAR; SCHED;
            STAGE(SB(1, 1), b3 + hB, voffB);
            WAIT_V(6); BAR; MMA(1, 1, At, B1); BAR;
        }
        epi.br = cur.br;
        { typename Epi::Pre pre[2][4][2];
#pragma unroll
            for (int ai = 0; ai < 2; ++ai)
#pragma unroll
                for (int m = 0; m < 4; ++m) { const int row = cur.brow + ai * HALF + wr * 64 + m * 16 + fr; const int rc = row < M ? row : M - 1;
#pragma unroll
                    for (int bj = 0; bj < 2; ++bj) pre[ai][m][bj] = epi.pre(rc, cur.bcol + bj * HALF + wc * 32 + fq * 8); }
#pragma unroll
            for (int ai = 0; ai < 2; ++ai)
#pragma unroll
                for (int m = 0; m < 4; ++m) { const int row = cur.brow + ai * HALF + wr * 64 + m * 16 + fr;
                    if (row < M) {
#pragma unroll
                        for (int bj = 0; bj < 2; ++bj) epi(row, cur.bcol + bj * HALF + wc * 32 + fq * 8, acc[ai][bj][m][0], acc[ai][bj][m][1], pre[ai][m][bj]); } } }
        if (!has_next) break;
#pragma unroll
        for (int a = 0; a < 2; ++a)
#pragma unroll
            for (int b = 0; b < 2; ++b)
#pragma unroll
                for (int m = 0; m < 4; ++m)
#pragma unroll
                    for (int n = 0; n < 2; ++n) acc[a][b][m][n] = (f32x4){0.f, 0.f, 0.f, 0.f};
        cur = nxt; cA = nA; cB = nB; ++ui;
    }
    WAIT_V(0);
    if (wr == 0) BAR;
    BAR;
    __syncthreads();
#undef SA
#undef SB
#undef STAGE
}
struct Enum1 { const bf16_t* U; const bf16_t* W; int x, j, nj;
    __device__ __forceinline__ bool get(int i, UnitDesc& u) const { const int v = j + nj * i; int pm, pn;
        if (v < 244) { pn = v >> 2; pm = x + 8 * (v & 3); } else { pn = x + 8 * (v - 244); pm = 32; if (pn >= 61) return false; }
        u.A = U; u.Bt = W; u.brow = pm * 256; u.bcol = pn * 256; u.br = 0; return true; } };
struct Enum1m { const bf16_t* U; const bf16_t* W; int x, j, nj, merged;
    __device__ __forceinline__ bool get(int i, UnitDesc& u) const { int v, pm, pn;
        if (!merged) v = j + nj * i;
        else if (j < 17) { if (i >= 7) return false; v = j + 32 * i; }
        else { if (i < 7) v = j + 32 * i; else if (i < 9) v = 224 + (j - 17) + 15 * (i - 7); else return false; }
        if (v < 244) { pn = v >> 2; pm = x + 8 * (v & 3); } else { pn = x + 8 * (v - 244); pm = 32; if (pn >= 61) return false; }
        u.A = U; u.Bt = W; u.brow = pm * 256; u.bcol = pn * 256; u.br = 0; return true; } };
struct Enum4 { const bf16_t* Z; const bf16_t* Wl; int x, j, nj;
    __device__ __forceinline__ bool get(int i, UnitDesc& u) const { const int v = j + nj * i; int br, pm, pn;
        if (v < 48) { br = v >> 4; pn = (v >> 2) & 3; pm = x + 8 * (v & 3); } else { const int e = x + 8 * (v - 48); if (e >= 12) return false; br = e >> 2; pn = e & 3; pm = 32; }
        u.A = Z + (br == 0 ? C_AQ : br == 1 ? C_RR : C_HQ); u.Bt = Wl + (size_t)br * 1024 * 1024; u.brow = pm * 256; u.bcol = pn * 256; u.br = br; return true; } };
struct Enum5 { const bf16_t* Gt; const bf16_t* Wl; int x, j, nj;
    __device__ __forceinline__ bool get(int i, UnitDesc& u) const { const int v = j + nj * i; int pm, pn;
        if (v < 16) { pn = v >> 2; pm = x + 8 * (v & 3); } else { const int e = x + 8 * (v - 16); if (e >= 4) return false; pn = e; pm = 32; }
        u.A = Gt; u.Bt = Wl; u.brow = pm * 256; u.bcol = pn * 256; u.br = 0; return true; } };

__device__ void rope_phase(const Params& p) {
    const int tid0 = otid(), bid0 = obid(), wave = tid0 >> 6, lane = tid0 & 63, d = lane & 31, qk = lane >> 5;
    bf16_t* Z = (bf16_t*)(p.ws + WS_Z);
    const float inv = 1.0f / powf(10000.0f, (float)(2 * d) / 64.0f);
    for (int m = bid0 * 8 + wave; m < MG; m += gridDim.x * 8) {
        const int t = m % LL; const float ang = (float)t * inv; float sn, cs; sincosf(ang, &sn, &cs);
        const float sc = qk == 0 ? 0.125f : 1.0f;
        bf16_t* base = Z + (size_t)m * ZS + qk * 1024 + d;
        bf16_t r1[16], r2[16];
#pragma unroll
        for (int hh = 0; hh < 16; ++hh) { r1[hh] = base[hh * 64]; r2[hh] = base[hh * 64 + 32]; }
#pragma unroll
        for (int hh = 0; hh < 16; ++hh) { const float x1 = bf2f(r1[hh]), x2 = bf2f(r2[hh]);
            base[hh * 64] = f2bf((x1 * cs - x2 * sn) * sc); base[hh * 64 + 32] = f2bf((x2 * cs + x1 * sn) * sc); }
    }
}

constexpr int NCH = 65;
constexpr int RC_VT = 18 * 1024, RC_SG = RC_VT + 4096, RC_BON = RC_SG + 4096, RC_BYTES = RC_BON + 256;
static_assert((size_t)64 * NCH * RC_BYTES <= WS_HM - WS_P, "chunk records overflow");
constexpr int WLDS = 19968;

__device__ __forceinline__ float half_sum(float v) {
    v = row16_sum(v); v += xor_lane<16>(v); return v;
}

__device__ void rwkv_summary(const Params& p, int l, int item, unsigned char* wl, int lane) {
    const int chain = item / NCH, ci = item % NCH, bl = chain >> 4, h = chain & 15, m0 = bl * LL, c0 = ci * 32, l31 = lane & 31, hh = lane >> 5;
    const bf16_t* Z = (const bf16_t*)(p.ws + WS_Z);
    unsigned char* rec = p.ws + WS_P + (size_t)item * RC_BYTES;
    const float* mu = p.mu + l * 4224;
    f32x16 dlo[2], alo[2];
#pragma unroll
    for (int nt = 0; nt < 2; ++nt)
#pragma unroll
        for (int r = 0; r < 16; ++r) { dlo[nt][r] = 0.f; alo[nt][r] = 0.f; }
    {
        const int t = c0 + l31, tc = t < LL ? t : LL - 1; const bf16_t* zr = Z + (size_t)(m0 + tc) * ZS;
        const bf16_t* WT = (const bf16_t*)(p.ws + WS_LR) + (size_t)(l * 2) * 65536; const bf16_t* AT = WT + 65536;
#pragma unroll
        for (int st = 0; st < 4; ++st) { const int j0 = 8 * hh + 16 * st;
            const u32x4 cw = *(const u32x4*)(zr + C_RWD + j0), ca = *(const u32x4*)(zr + C_RAD + j0);
            u32x4 pw = {0u, 0u, 0u, 0u}, pa = {0u, 0u, 0u, 0u}; if (tc > 0) { pw = *(const u32x4*)(zr - ZS + C_RWD + j0); pa = *(const u32x4*)(zr - ZS + C_RAD + j0); }
            u32x4 fw, fa;
#pragma unroll
            for (int q = 0; q < 4; ++q) { const float m0w = mu[4096 + j0 + 2 * q], m1w = mu[4096 + j0 + 2 * q + 1], m0a = mu[4160 + j0 + 2 * q], m1a = mu[4160 + j0 + 2 * q + 1];
                const float c0w = lo2f(cw[q]), c1w = hi2f(cw[q]), c0a = lo2f(ca[q]), c1a = hi2f(ca[q]);
                fw[q] = pk2(tanh_fast(c0w + (lo2f(pw[q]) - c0w) * m0w), tanh_fast(c1w + (hi2f(pw[q]) - c1w) * m1w));
                fa[q] = pk2(c0a + (lo2f(pa[q]) - c0a) * m0a, c1a + (hi2f(pa[q]) - c1a) * m1a); }
#pragma unroll
            for (int nt = 0; nt < 2; ++nt) { const size_t wo = (size_t)(h * 64 + 32 * nt + l31) * 64 + j0;
                dlo[nt] = mfma32(__builtin_bit_cast(bf16x8, fw), *(const bf16x8*)(WT + wo), dlo[nt]);
                alo[nt] = mfma32(__builtin_bit_cast(bf16x8, fa), *(const bf16x8*)(AT + wo), alo[nt]); }
            __builtin_amdgcn_sched_barrier(0); }
    }
    float KK[2][16], KT[2][16], XR[2][16];
    float gamC[2];
#pragma unroll
    for (int nt = 0; nt < 2; ++nt) {
        const int c = h * 64 + 32 * nt + l31; const int pc = l * 1024 + c;
        const float w0 = p.w0[pc], a0 = p.a0[pc], kkc = p.k_k[pc], kac = p.k_a[pc], mr = mu[c], mk = mu[1024 + c], mv = mu[2048 + c], mgc = mu[3072 + c];
#pragma unroll
        for (int q = 0; q < 4; ++q) { float xv4[4], sg4[4];
#pragma unroll
            for (int e = 0; e < 4; ++e) { const int r = 4 * q + e, tt = 8 * q + 4 * hh + e, t = c0 + tt; const bool valid = t < LL; const int tc = valid ? t : LL - 1;
                const bf16_t* zr = Z + (size_t)(m0 + tc) * ZS + c;
                const float r0 = bf2f(zr[C_RR]), k0 = bf2f(zr[C_RK]), v0 = bf2f(zr[C_RV]), g0 = bf2f(zr[C_RG]);
                float rp = 0.f, kp = 0.f, vp = 0.f, gp = 0.f; if (tc > 0) { rp = bf2f(zr[C_RR - ZS]); kp = bf2f(zr[C_RK - ZS]); vp = bf2f(zr[C_RV - ZS]); gp = bf2f(zr[C_RG - ZS]); }
                float xr = r0 + (rp - r0) * mr, xk = k0 + (kp - k0) * mk, xv = v0 + (vp - v0) * mv; const float xg = g0 + (gp - g0) * mgc;
                const float y = -(w0 + dlo[nt][r]); const float sp = y > 20.f ? y : __logf(1.0f + __expf(y));
                float lw = -__expf(-sp - 0.5f);
                const float al = sigm(a0 + alo[nt][r]);
                if (!valid) { xr = 0.f; xk = 0.f; xv = 0.f; lw = 0.f; }
                dlo[nt][r] = lw; alo[nt][r] = al; XR[nt][r] = xr; KK[nt][r] = xk * kkc; KT[nt][r] = xk * (1.0f + (al - 1.0f) * kac);
                xv4[e] = xv; sg4[e] = silu(xg); }
            u32x2 o; o.x = pk2(xv4[0], xv4[1]); o.y = pk2(xv4[2], xv4[3]); *(u32x2*)(rec + RC_VT + (32 * nt + l31) * 64 + (8 * q + 4 * hh) * 2) = o;
            o.x = pk2(sg4[0], sg4[1]); o.y = pk2(sg4[2], sg4[3]); *(u32x2*)(rec + RC_SG + (32 * nt + l31) * 64 + (8 * q + 4 * hh) * 2) = o;
            if (q & 1) __builtin_amdgcn_sched_barrier(0); }
    }
    {
        const float rk0 = p.r_k[l * 1024 + h * 64 + l31], rk1 = p.r_k[l * 1024 + h * 64 + 32 + l31];
#pragma unroll
        for (int r = 0; r < 16; ++r) { const float ss = half_sum(KK[0][r] * KK[0][r] + KK[1][r] * KK[1][r]); const float inv = rsqrtf(fmaxf(ss, 1e-24f)); KK[0][r] *= inv; KK[1][r] *= inv;
            const float bon = half_sum(XR[0][r] * KT[0][r] * rk0 + XR[1][r] * KT[1][r] * rk1);
            if (l31 == 0) ((bf16_t*)(rec + RC_BON))[(r & 3) + 8 * (r >> 2) + 4 * hh] = f2bf(bon); }
    }
#pragma unroll
    for (int nt = 0; nt < 2; ++nt) { float tot[4], ptot[4];
#pragma unroll
        for (int q = 0; q < 4; ++q) { dlo[nt][4 * q + 1] += dlo[nt][4 * q]; dlo[nt][4 * q + 2] += dlo[nt][4 * q + 1]; dlo[nt][4 * q + 3] += dlo[nt][4 * q + 2]; tot[q] = dlo[nt][4 * q + 3]; }
#pragma unroll
        for (int q = 0; q < 4; ++q) ptot[q] = __shfl_xor(tot[q], 32);
        float off = 0.f;
#pragma unroll
        for (int q = 0; q < 4; ++q) { const float t0 = hh ? ptot[q] : tot[q], t1 = hh ? tot[q] : ptot[q]; const float mine = off + (hh ? t0 : 0.f);
#pragma unroll
            for (int e = 0; e < 4; ++e) dlo[nt][4 * q + e] += mine;
            off += t0 + t1; }
        gamC[nt] = off; }
    bf16_t* Bh = (bf16_t*)wl; bf16_t* Kh = Bh + 32 * 72; bf16_t* Atl = Kh + 32 * 72; bf16_t* Rt = Atl + 32 * 72;
    u32x4* kstash = (u32x4*)(rec + 8 * 1024);
#pragma unroll
    for (int nt = 0; nt < 2; ++nt) { unsigned aw[8], bw[8], kw[8];
#pragma unroll
        for (int q = 0; q < 4; ++q) {
            const float plast = __shfl_xor(dlo[nt][4 * q + 3], 32); const float plastp = q > 0 ? __shfl_xor(dlo[nt][4 * (q > 0 ? q - 1 : 0) + 3], 32) : 0.f;
            float prevc = hh ? plast : plastp; float at[4], bc[4], kc[4];
#pragma unroll
            for (int e = 0; e < 4; ++e) { const int r = 4 * q + e, tt = 8 * q + 4 * hh + e; const float cum = dlo[nt][r];
                const float g = __expf(cum), ig = __expf(-cum), gce = __expf(gamC[nt] - cum), gp = __expf(prevc); prevc = cum;
                const float bb = KK[nt][r] * alo[nt][r];
                at[e] = -KK[nt][r] * gp; bc[e] = bb * gce; kc[e] = KT[nt][r] * gce;
                Bh[tt * 72 + 32 * nt + l31] = f2bf(bb * ig); Kh[tt * 72 + 32 * nt + l31] = f2bf(KT[nt][r] * ig); Rt[tt * 72 + 32 * nt + l31] = f2bf(XR[nt][r] * g); Atl[tt * 72 + 32 * nt + l31] = f2bf(at[e]); }
            aw[2 * q] = pk2(at[0], at[1]); aw[2 * q + 1] = pk2(at[2], at[3]); bw[2 * q] = pk2(bc[0], bc[1]); bw[2 * q + 1] = pk2(bc[2], bc[3]);
            kw[2 * q] = pk2(kc[0], kc[1]); kw[2 * q + 1] = pk2(kc[2], kc[3]);
            __builtin_amdgcn_sched_barrier(0); }
#pragma unroll
        for (int st = 0; st < 2; ++st) { u32x4 wa, wb; wa.x = aw[4 * st]; wa.y = aw[4 * st + 1]; wa.z = aw[4 * st + 2]; wa.w = aw[4 * st + 3]; wb.x = bw[4 * st]; wb.y = bw[4 * st + 1]; wb.z = bw[4 * st + 2]; wb.w = bw[4 * st + 3];
            ((u32x4*)rec)[(nt * 2 + st) * 64 + lane] = wa; ((u32x4*)rec)[(4 + nt * 2 + st) * 64 + lane] = wb;
            u32x4 wk; wk.x = kw[4 * st]; wk.y = kw[4 * st + 1]; wk.z = kw[4 * st + 2]; wk.w = kw[4 * st + 3]; kstash[(nt * 2 + st) * 64 + lane] = wk; }
    }
    const float gC0 = __expf(gamC[0]), gC1 = __expf(gamC[1]);
    asm volatile("s_waitcnt lgkmcnt(0)" ::: "memory");
    f32x16 Nab, Nak, Mbr, Mkr;
#pragma unroll
    for (int r = 0; r < 16; ++r) { Nab[r] = 0.f; Nak[r] = 0.f; Mbr[r] = 0.f; Mkr[r] = 0.f; }
#pragma unroll
    for (int st = 0; st < 4; ++st) { const int o = l31 * 72 + 8 * hh + 16 * st;
        const bf16x8 fb = *(const bf16x8*)(Bh + o), fk = *(const bf16x8*)(Kh + o), fa = *(const bf16x8*)(Atl + o), fr = *(const bf16x8*)(Rt + o);
        Nab = mfma32(fb, fa, Nab); Nak = mfma32(fk, fa, Nak); Mbr = mfma32(fb, fr, Mbr); Mkr = mfma32(fk, fr, Mkr); }
    f32x16 Rp[2];
#pragma unroll
    for (int mt = 0; mt < 2; ++mt)
#pragma unroll
        for (int q = 0; q < 4; ++q) { const u32x2 v = *(const u32x2*)(Rt + l31 * 72 + 32 * mt + 8 * q + 4 * hh);
            Rp[mt][4 * q] = lo2f(v.x); Rp[mt][4 * q + 1] = hi2f(v.x); Rp[mt][4 * q + 2] = lo2f(v.y); Rp[mt][4 * q + 3] = hi2f(v.y); }
#pragma unroll
    for (int r = 0; r < 16; ++r) { const int s = (r & 3) + 8 * (r >> 2) + 4 * hh; if (s >= l31) { Nab[r] = 0.f; Nak[r] = 0.f; } if (s > l31) { Mbr[r] = 0.f; Mkr[r] = 0.f; } }
    asm volatile("s_waitcnt lgkmcnt(0)" ::: "memory");
    float* Nl = (float*)wl; bf16_t* NakL = (bf16_t*)(wl + 4096);
#pragma unroll
    for (int r = 0; r < 16; ++r) { const int s = (r & 3) + 8 * (r >> 2) + 4 * hh; Nl[s * 32 + l31] = Nab[r]; NakL[s * 40 + l31] = f2bf(Nak[r]); }
    asm volatile("s_waitcnt lgkmcnt(0)" ::: "memory");
    float T[32];
#pragma unroll
    for (int s = 31; s >= 0; --s) { float acc = (s == l31) ? 1.0f : 0.0f;
#pragma unroll
        for (int s2 = s + 1; s2 < 32; ++s2) acc += Nl[s * 32 + s2] * T[s2];
        T[s] = acc; }
    bf16x8 Tf[2];
#pragma unroll
    for (int st = 0; st < 2; ++st) { u32x4 w;
#pragma unroll
        for (int q = 0; q < 4; ++q) { const int sa = 16 * st + 8 * (q >> 1) + 2 * (q & 1); w[q] = hh ? pk2(T[sa + 4], T[sa + 5]) : pk2(T[sa], T[sa + 1]); }
        Tf[st] = __builtin_bit_cast(bf16x8, w); }
    bf16x8 AtP[2][2], BcP[2][2];
#pragma unroll
    for (int nt = 0; nt < 2; ++nt)
#pragma unroll
        for (int st = 0; st < 2; ++st) { AtP[nt][st] = ((const bf16x8*)rec)[(nt * 2 + st) * 64 + lane]; BcP[nt][st] = ((const bf16x8*)rec)[(4 + nt * 2 + st) * 64 + lane]; }
    f32x16 ApT[2], W1T;
#pragma unroll
    for (int r = 0; r < 16; ++r) { ApT[0][r] = 0.f; ApT[1][r] = 0.f; W1T[r] = 0.f; }
#pragma unroll
    for (int st = 0; st < 2; ++st) { ApT[0] = mfma32(Tf[st], AtP[0][st], ApT[0]); ApT[1] = mfma32(Tf[st], AtP[1][st], ApT[1]);
        const bf16_t* nk = NakL + l31 * 40 + 16 * st + 4 * hh; W1T = mfma32(Tf[st], ld44(nk, nk + 8), W1T); }
    mfma_settle(ApT[0]); mfma_settle(ApT[1]); mfma_settle(W1T);
    bf16x8 ApF[2][2], W1F[2], MbF[2];
#pragma unroll
    for (int st = 0; st < 2; ++st) { ApF[0][st] = pack8(ApT[0], st); ApF[1][st] = pack8(ApT[1], st); W1F[st] = pack8(W1T, st); MbF[st] = pack8(Mbr, st); }
    bf16x8* out = (bf16x8*)rec;
#pragma unroll
    for (int jt = 0; jt < 2; ++jt) {
#pragma unroll
        for (int j2 = 0; j2 < 2; ++j2) { f32x16 G;
#pragma unroll
            for (int r = 0; r < 16; ++r) G[r] = (jt == j2 && ((r & 3) + 8 * (r >> 2) + 4 * hh) == l31) ? (j2 ? gC1 : gC0) : 0.f;
            G = mfma32(ApF[jt][0], BcP[j2][0], G); G = mfma32(ApF[jt][1], BcP[j2][1], G); mfma_settle(G);
            out[((jt * 2 + j2) * 2 + 0) * 64 + lane] = pack8(G, 0); out[((jt * 2 + j2) * 2 + 1) * 64 + lane] = pack8(G, 1); }
        Rp[jt] = mfma32(ApF[jt][0], MbF[0], Rp[jt]); Rp[jt] = mfma32(ApF[jt][1], MbF[1], Rp[jt]); mfma_settle(Rp[jt]);
        out[(12 + jt * 2 + 0) * 64 + lane] = pack8(Rp[jt], 0); out[(12 + jt * 2 + 1) * 64 + lane] = pack8(Rp[jt], 1); }
#pragma unroll
    for (int j2 = 0; j2 < 2; ++j2) { f32x16 H;
#pragma unroll
        for (int st = 0; st < 2; ++st) { const u32x4 wk = kstash[(j2 * 2 + st) * 64 + lane];
#pragma unroll
            for (int q = 0; q < 4; ++q) { H[8 * st + 2 * q] = lo2f(wk[q]); H[8 * st + 2 * q + 1] = hi2f(wk[q]); } }
        H = mfma32(W1F[0], BcP[j2][0], H); H = mfma32(W1F[1], BcP[j2][1], H); mfma_settle(H);
        out[(8 + j2 * 2 + 0) * 64 + lane] = pack8(H, 0); out[(8 + j2 * 2 + 1) * 64 + lane] = pack8(H, 1); }
    Mkr = mfma32(W1F[0], MbF[0], Mkr); Mkr = mfma32(W1F[1], MbF[1], Mkr); mfma_settle(Mkr);
    out[(16 + 0) * 64 + lane] = pack8(Mkr, 0); out[(16 + 1) * 64 + lane] = pack8(Mkr, 1);
    asm volatile("s_waitcnt lgkmcnt(0)" ::: "memory");
}

__device__ void rwkv_seq(const Params& p, int l, int chain, int it, int lane, float* ex, int cl, unsigned char* wstage) {
    LAS unsigned char* wl = (LAS unsigned char*)wstage;
    const int bl = chain >> 4, h = chain & 15, m0 = bl * LL, l31 = lane & 31, hh = lane >> 5;
    bf16_t* Z = (bf16_t*)(p.ws + WS_Z);
    f32x16 ST[2];
#pragma unroll
    for (int a = 0; a < 2; ++a)
#pragma unroll
        for (int r = 0; r < 16; ++r) ST[a][r] = 0.f;
    const float gw0 = p.gn_w[l * 1024 + h * 64 + 32 * it + l31], gb0 = p.gn_b[l * 1024 + h * 64 + 32 * it + l31];
    bf16x8 vb[2], vbn[2];
#define RW_LOAD(ci_) do { const unsigned char* rc_ = p.ws + WS_P + (size_t)(chain * NCH + (ci_)) * RC_BYTES; \
        _Pragma("unroll") for (int f = 0; f < 18; ++f) __builtin_amdgcn_global_load_lds((const unsigned*)(rc_ + f * 1024 + lane * 16), (LAS unsigned*)(wl + f * 1024), 16, 0, 0); \
        _Pragma("unroll") for (int st = 0; st < 2; ++st) { const bf16_t* vp_ = (const bf16_t*)(rc_ + RC_VT) + (32 * it + l31) * 32 + 16 * st + 4 * hh; \
            const u32x2 a_ = *(const u32x2*)vp_, b_ = *(const u32x2*)(vp_ + 8); u32x4 w_; w_.x = a_.x; w_.y = a_.y; w_.z = b_.x; w_.w = b_.y; vbn[st] = __builtin_bit_cast(bf16x8, w_); } } while (0)
    RW_LOAD(0); vb[0] = vbn[0]; vb[1] = vbn[1];
    for (int ci = 0; ci < NCH; ++ci) {
        const unsigned char* rec = p.ws + WS_P + (size_t)(chain * NCH + ci) * RC_BYTES;
        asm volatile("s_waitcnt vmcnt(0)" ::: "memory");
        bf16x8 fr[18];
#pragma unroll
        for (int f = 0; f < 18; ++f) fr[f] = *(const LAS bf16x8*)(wl + f * 1024 + lane * 16);
        bf16x8 sp[2][2];
#pragma unroll
        for (int jt = 0; jt < 2; ++jt) { sp[jt][0] = pack8(ST[jt], 0); sp[jt][1] = pack8(ST[jt], 1); }
        u32x2 ev[4], es[4], bon[4];
#pragma unroll
        for (int q = 0; q < 4; ++q) { ev[q] = *(const u32x2*)(rec + RC_VT + (32 * it + l31) * 64 + (8 * q + 4 * hh) * 2); es[q] = *(const u32x2*)(rec + RC_SG + (32 * it + l31) * 64 + (8 * q + 4 * hh) * 2);
            bon[q] = *(const u32x2*)(rec + RC_BON + (8 * q + 4 * hh) * 2); }
        asm volatile("s_waitcnt lgkmcnt(0)" ::: "memory");
        if (ci + 1 < NCH) RW_LOAD(ci + 1);
        f32x16 O;
#pragma unroll
        for (int r = 0; r < 16; ++r) O[r] = 0.f;
#pragma unroll
        for (int jt = 0; jt < 2; ++jt)
#pragma unroll
            for (int st = 0; st < 2; ++st) O = mfma32(fr[12 + jt * 2 + st], sp[jt][st], O);
#pragma unroll
        for (int st = 0; st < 2; ++st) O = mfma32(fr[16 + st], vb[st], O);
#pragma unroll
        for (int j2 = 0; j2 < 2; ++j2) { f32x16 Sn;
#pragma unroll
            for (int r = 0; r < 16; ++r) Sn[r] = 0.f;
#pragma unroll
            for (int jt = 0; jt < 2; ++jt)
#pragma unroll
                for (int st = 0; st < 2; ++st) Sn = mfma32(fr[(jt * 2 + j2) * 2 + st], sp[jt][st], Sn);
#pragma unroll
            for (int st = 0; st < 2; ++st) Sn = mfma32(fr[8 + j2 * 2 + st], vb[st], Sn);
            ST[j2] = Sn; }
        vb[0] = vbn[0]; vb[1] = vbn[1];
        float* exw = ex + ((ci & 1) * 8 + cl * 2) * 64;
        {
            float a[16], b[16];
#pragma unroll
            for (int r = 0; r < 16; ++r) { a[r] = O[r]; b[r] = O[r] * O[r]; }
#define RW_STEP(n, m) _Pragma("unroll") for (int k = 0; k < (n); ++k) { const bool up = (l31 & (m)) != 0; \
                const float ka = up ? a[k + (n)] : a[k], sa = up ? a[k] : a[k + (n)], kb = up ? b[k + (n)] : b[k], sb = up ? b[k] : b[k + (n)]; \
                a[k] = ka + xor_lane<(m)>(sa); b[k] = kb + xor_lane<(m)>(sb); }
            RW_STEP(8, 16) RW_STEP(4, 8) RW_STEP(2, 4) RW_STEP(1, 2)
#undef RW_STEP
            a[0] += xor_lane<1>(a[0]); b[0] += xor_lane<1>(b[0]);
            if ((l31 & 1) == 0) { const int r = l31 >> 1, tt = (r & 3) + 8 * (r >> 2) + 4 * hh; exw[it * 64 + tt * 2] = a[0]; exw[it * 64 + tt * 2 + 1] = b[0]; }
        }
        asm volatile("s_waitcnt lgkmcnt(0)" ::: "memory"); __builtin_amdgcn_s_barrier(); asm volatile("" ::: "memory");
        bf16_t* Zc = Z + (size_t)(m0 + ci * 32) * ZS + C_RR + h * 64 + 32 * it; const unsigned voff = (unsigned)(4 * hh) * ZS + l31;
#pragma unroll
        for (int q = 0; q < 4; ++q)
#pragma unroll
            for (int e = 0; e < 4; ++e) { const int r = 4 * q + e, tt = 8 * q + 4 * hh + e, t = ci * 32 + tt;
                const float ps1 = exw[tt * 2] + exw[64 + tt * 2], ps2 = exw[tt * 2 + 1] + exw[64 + tt * 2 + 1];
                const float mean = ps1 * (1.0f / 64.0f), var = fmaxf(ps2 * (1.0f / 64.0f) - mean * mean, 0.f);
                const float rs = rsqrtf(var + 64e-5f), d0 = O[r] - mean;
                const unsigned vv0 = e < 2 ? ev[q].x : ev[q].y, ss0 = e < 2 ? es[q].x : es[q].y;
                const float va = (e & 1) ? hi2f(vv0) : lo2f(vv0), sa = (e & 1) ? hi2f(ss0) : lo2f(ss0);
                const float y0 = (d0 * rs * gw0 + gb0 + ((e & 1) ? hi2f(e < 2 ? bon[q].x : bon[q].y) : lo2f(e < 2 ? bon[q].x : bon[q].y)) * va) * sa;
                if (t < LL) Zc[(unsigned)(8 * q + e) * ZS + voff] = f2bf(y0); }
    }
#undef RW_LOAD
}

constexpr size_t WS_HS = WS_P + (size_t)64 * NCH * RC_BYTES;
constexpr int HS_BYTES = 3072;
constexpr size_t WS_HL = WS_HS + (size_t)32 * NCH * HS_BYTES;
static_assert(WS_HL + (size_t)32 * 24576 <= WS_HM, "hgrn side records overflow");

__device__ __forceinline__ bf16_t* hfrag(const Params& p, int bl, int h, int ci, int arr, int f, int lane) {
    if (ci < 64) return (bf16_t*)(p.ws + WS_Z) + (size_t)(bl * LL + ci * 32 + 4 * f + (lane >> 4)) * ZS + (arr == 0 ? C_HQ : arr == 1 ? C_HF : C_HI) + h * 128 + (lane & 15) * 8;
    return (bf16_t*)(p.ws + WS_HL + (size_t)(bl * 8 + h) * 24576 + (arr * 8 + f) * 1024 + lane * 16);
}

__device__ void hgrn_summary(const Params& p, int l, int item, unsigned char* smem) {
    const int chain = item / NCH, ci = item % NCH, bl = chain >> 3, h = chain & 7, m0 = bl * LL, tid = otid(), w = tid >> 6, lane = tid & 63, l31 = lane & 31, hh = lane >> 5;
    float* Gf = (float*)smem; float* Qf = (float*)(smem + 16384); float* Kf = (float*)(smem + 32768); float* dec = (float*)(smem + 49152);
    bf16_t* Qh = (bf16_t*)(smem + 49664); bf16_t* Kc = (bf16_t*)(smem + 58368); bf16_t* KbT = (bf16_t*)(smem + 67072); bf16_t* VT = (bf16_t*)(smem + 77312);
    bf16_t* attL = (bf16_t*)(smem + 87552);
    const bf16_t* Z = (const bf16_t*)(p.ws + WS_Z);
    const int t0 = ci * 32;
    {
        const int tt = tid >> 4, k0 = (tid & 15) * 8, t = t0 + tt; const bool valid = t < LL; const int tc = valid ? t : LL - 1;
        bf16_t* zr = (bf16_t*)(p.ws + WS_Z) + (size_t)(m0 + tc) * ZS + h * 128 + k0;
        const u32x4 wq = *(const u32x4*)(zr + C_HQ), wf = *(const u32x4*)(zr + C_HF), wi = *(const u32x4*)(zr + C_HI), wg = *(const u32x4*)(zr + C_HG);
        f32x4 lb0 = {0.f, 0.f, 0.f, 0.f}, lb1 = {0.f, 0.f, 0.f, 0.f};
        if (l == 1) { const f32x4 a0 = *(const f32x4*)(p.hlb + h * 128 + k0), a1 = *(const f32x4*)(p.hlb + h * 128 + k0 + 4), b0 = *(const f32x4*)(p.hlb + 1024 + h * 128 + k0), b1 = *(const f32x4*)(p.hlb + 1024 + h * 128 + k0 + 4);
#pragma unroll
            for (int j = 0; j < 4; ++j) { lb0[j] = __builtin_amdgcn_rcpf(1.0f + __expf(a0[j] - b0[j])); lb1[j] = __builtin_amdgcn_rcpf(1.0f + __expf(a1[j] - b1[j])); } }
        float g[8], q[8], kk[8], sg[8];
#pragma unroll
        for (int j = 0; j < 8; ++j) { const unsigned uq = wq[j >> 1], uf = wf[j >> 1], ug = wg[j >> 1];
            const float hq = (j & 1) ? hi2f(uq) : lo2f(uq), hf = (j & 1) ? hi2f(uf) : lo2f(uf), hg = (j & 1) ? hi2f(ug) : lo2f(ug), lb = j < 4 ? lb0[j & 3] : lb1[j & 3];
            const float fg = lb + (1.0f - lb) * sigm(hf);
            g[j] = valid ? __logf(fg) : 0.f; q[j] = valid ? silu(hq) : 0.f; kk[j] = valid ? 1.0f - fg : 0.f; sg[j] = silu(hg);
            const unsigned ui = wi[j >> 1]; VT[(k0 + j) * 40 + tt] = valid ? (bf16_t)((j & 1) ? (ui >> 16) : (ui & 0xffffu)) : (bf16_t)0; }
        *(f32x4*)(Gf + tt * 128 + k0) = (f32x4){g[0], g[1], g[2], g[3]}; *(f32x4*)(Gf + tt * 128 + k0 + 4) = (f32x4){g[4], g[5], g[6], g[7]};
        *(f32x4*)(Qf + tt * 128 + k0) = (f32x4){q[0], q[1], q[2], q[3]}; *(f32x4*)(Qf + tt * 128 + k0 + 4) = (f32x4){q[4], q[5], q[6], q[7]};
        *(f32x4*)(Kf + tt * 128 + k0) = (f32x4){kk[0], kk[1], kk[2], kk[3]}; *(f32x4*)(Kf + tt * 128 + k0 + 4) = (f32x4){kk[4], kk[5], kk[6], kk[7]};
        if (valid) { u32x4 og; og.x = pk2(sg[0], sg[1]); og.y = pk2(sg[2], sg[3]); og.z = pk2(sg[4], sg[5]); og.w = pk2(sg[6], sg[7]); *(u32x4*)(zr + C_HG) = og; }
    }
    __syncthreads();
    if (tid < 128) { float run = 0.f;
#pragma unroll
        for (int tt = 0; tt < 32; ++tt) { run += Gf[tt * 128 + tid]; Gf[tt * 128 + tid] = run; } dec[tid] = __expf(run); }
    __syncthreads();
    for (int e = 0; e < 8; ++e) { const int idx = tid + NTH * e, tt = idx >> 7, k = idx & 127; const float lam = Gf[idx], le = Gf[31 * 128 + k], q = Qf[idx], kk = Kf[idx];
        Qh[tt * 136 + k] = f2bf(q * __expf(lam)); Kc[tt * 136 + k] = f2bf(kk * __expf(-lam)); KbT[k * 40 + tt] = f2bf(kk * __expf(le - lam)); }
    __syncthreads();
    unsigned char* side = p.ws + WS_HS + (size_t)item * HS_BYTES;
    {
        const int kt = w >> 1, s = w & 1; const bf16_t* qa = Qh + l31 * 136 + 32 * kt + 16 * s + 4 * hh;
        *(bf16x8*)hfrag(p, bl, h, ci, 0, w, lane) = ld44(qa, qa + 8);
        *(bf16x8*)hfrag(p, bl, h, ci, 1, w, lane) = *(const bf16x8*)(KbT + (32 * kt + l31) * 40 + 16 * s + 8 * hh);
        *(bf16x8*)hfrag(p, bl, h, ci, 2, w, lane) = *(const bf16x8*)(VT + (32 * kt + l31) * 40 + 16 * s + 8 * hh);
        if (tid < 128) ((float*)(side + 2048))[tid] = dec[tid];
    }
    if (w == 0) {
        f32x16 X;
#pragma unroll
        for (int r = 0; r < 16; ++r) X[r] = 0.f;
#pragma unroll
        for (int s8 = 0; s8 < 8; ++s8) X = mfma32(*(const bf16x8*)(Kc + l31 * 136 + 16 * s8 + 8 * hh), *(const bf16x8*)(Qh + l31 * 136 + 16 * s8 + 8 * hh), X);
#pragma unroll
        for (int r = 0; r < 16; ++r) { const int srow = (r & 3) + 8 * (r >> 2) + 4 * hh; attL[l31 * 40 + srow] = f2bf(srow > l31 ? 0.f : X[r]); }
        asm volatile("s_waitcnt lgkmcnt(0)" ::: "memory");
#pragma unroll
        for (int st = 0; st < 2; ++st) ((bf16x8*)side)[st * 64 + lane] = *(const bf16x8*)(attL + l31 * 40 + 16 * st + 8 * hh);
    }
    __syncthreads();
}

__device__ void hgrn_seq(const Params& p, int l, int chain, unsigned char* smem) {
    const int bl = chain >> 3, h = chain & 7, m0 = bl * LL, tid = otid(), w = tid >> 6, lane = tid & 63, l31 = lane & 31, hh = lane >> 5;
    float* Ob = (float*)smem;
    bf16_t* Z = (bf16_t*)(p.ws + WS_Z);
    const int vt = w & 3, kt0 = 2 * (w >> 2);
    f32x16 S[2];
#pragma unroll
    for (int r = 0; r < 16; ++r) { S[0][r] = 0.f; S[1][r] = 0.f; }
    bf16x8 qf[2][2], kf[2][2], vf[2], af[2]; f32x4 dv[2][4];
    const bf16_t* pq[2][2]; const bf16_t* pk[2][2]; const bf16_t* pv[2];
#pragma unroll
    for (int k2 = 0; k2 < 2; ++k2)
#pragma unroll
        for (int s = 0; s < 2; ++s) { pq[k2][s] = hfrag(p, bl, h, 0, 0, (kt0 + k2) * 2 + s, lane); pk[k2][s] = hfrag(p, bl, h, 0, 1, (kt0 + k2) * 2 + s, lane); }
#pragma unroll
    for (int s = 0; s < 2; ++s) pv[s] = hfrag(p, bl, h, 0, 2, vt * 2 + s, lane);
#define HG_LOAD(ci_) do { const unsigned char* sd_ = p.ws + WS_HS + (size_t)(chain * NCH + (ci_)) * HS_BYTES; \
        if ((ci_) < 64) { const size_t co_ = (size_t)(ci_) * 32 * ZS; \
            _Pragma("unroll") for (int k2 = 0; k2 < 2; ++k2) _Pragma("unroll") for (int s = 0; s < 2; ++s) { qf[k2][s] = *(const bf16x8*)(pq[k2][s] + co_); kf[k2][s] = *(const bf16x8*)(pk[k2][s] + co_); } \
            _Pragma("unroll") for (int s = 0; s < 2; ++s) vf[s] = *(const bf16x8*)(pv[s] + co_); \
        } else { \
            _Pragma("unroll") for (int k2 = 0; k2 < 2; ++k2) _Pragma("unroll") for (int s = 0; s < 2; ++s) { qf[k2][s] = *(const bf16x8*)hfrag(p, bl, h, 64, 0, (kt0 + k2) * 2 + s, lane); kf[k2][s] = *(const bf16x8*)hfrag(p, bl, h, 64, 1, (kt0 + k2) * 2 + s, lane); } \
            _Pragma("unroll") for (int s = 0; s < 2; ++s) vf[s] = *(const bf16x8*)hfrag(p, bl, h, 64, 2, vt * 2 + s, lane); } \
        _Pragma("unroll") for (int s = 0; s < 2; ++s) af[s] = ((const bf16x8*)sd_)[s * 64 + lane]; \
        _Pragma("unroll") for (int k2 = 0; k2 < 2; ++k2) _Pragma("unroll") for (int q = 0; q < 4; ++q) dv[k2][q] = *(const f32x4*)((const float*)(sd_ + 2048) + 32 * (kt0 + k2) + 8 * q + 4 * hh); } while (0)
    HG_LOAD(0);
    const f32x4 nw0 = *(const f32x4*)(p.hnw + l * 128 + (tid & 15) * 8), nw1 = *(const f32x4*)(p.hnw + l * 128 + (tid & 15) * 8 + 4);
    for (int ci = 0; ci < NCH; ++ci) {
        const int t0 = ci * 32;
        u32x4 gg = {0u, 0u, 0u, 0u}; { const int tg = t0 + (tid >> 4); if (tg < LL) gg = *(const u32x4*)(Z + (size_t)(m0 + tg) * ZS + h * 128 + (tid & 15) * 8 + C_HG); }
        f32x16 O;
#pragma unroll
        for (int r = 0; r < 16; ++r) O[r] = 0.f;
#pragma unroll
        for (int k2 = 0; k2 < 2; ++k2)
#pragma unroll
            for (int s = 0; s < 2; ++s) O = mfma32(qf[k2][s], pack8(S[k2], s), O);
        if (w < 4) { O = mfma32(af[0], vf[0], O); O = mfma32(af[1], vf[1], O); }
#pragma unroll
        for (int k2 = 0; k2 < 2; ++k2) {
#pragma unroll
            for (int r = 0; r < 16; ++r) S[k2][r] *= dv[k2][r >> 2][r & 3];
#pragma unroll
            for (int st = 0; st < 2; ++st) S[k2] = mfma32(kf[k2][st], vf[st], S[k2]); }
        if (ci + 1 < NCH) HG_LOAD(ci + 1);
        float* Obw = Ob + ((ci & 1) * 2 + (w >> 2)) * (32 * 132);
#pragma unroll
        for (int r = 0; r < 16; ++r) Obw[((r & 3) + 8 * (r >> 2) + 4 * hh) * 132 + 32 * vt + l31] = O[r];
        __syncthreads();
        { const int tt = tid >> 4, v0 = (tid & 15) * 8, t = t0 + tt; const float* oa = Ob + ((ci & 1) * 2) * (32 * 132) + tt * 132 + v0; const float* ob = oa + 32 * 132;
            const f32x4 a0 = *(const f32x4*)oa, a1 = *(const f32x4*)(oa + 4), b0 = *(const f32x4*)ob, b1 = *(const f32x4*)(ob + 4);
            float o[8]; float ss = 0.f;
#pragma unroll
            for (int j = 0; j < 4; ++j) { o[j] = a0[j] + b0[j]; o[4 + j] = a1[j] + b1[j]; }
#pragma unroll
            for (int j = 0; j < 8; ++j) ss += o[j] * o[j];
            ss = row16_sum(ss);
            const float rn = rsqrtf(ss * (1.0f / 128.0f) + 1e-6f);
            if (t < LL) { bf16_t* zr = Z + (size_t)(m0 + t) * ZS + h * 128 + v0;
                u32x4 ov; ov.x = pk2(o[0] * rn * nw0[0] * lo2f(gg.x), o[1] * rn * nw0[1] * hi2f(gg.x)); ov.y = pk2(o[2] * rn * nw0[2] * lo2f(gg.y), o[3] * rn * nw0[3] * hi2f(gg.y));
                ov.z = pk2(o[4] * rn * nw1[0] * lo2f(gg.z), o[5] * rn * nw1[1] * hi2f(gg.z)); ov.w = pk2(o[6] * rn * nw1[2] * lo2f(gg.w), o[7] * rn * nw1[3] * hi2f(gg.w));
                *(u32x4*)(zr + C_HQ) = ov; } }
    }
    __syncthreads();
#undef HG_LOAD
}

#define TR16(o, a) asm volatile( \
    "ds_read_b64_tr_b16 %0, %16 offset:0\n\tds_read_b64_tr_b16 %1, %16 offset:2176\n\tds_read_b64_tr_b16 %2, %16 offset:64\n\tds_read_b64_tr_b16 %3, %16 offset:2240\n\t" \
    "ds_read_b64_tr_b16 %4, %16 offset:128\n\tds_read_b64_tr_b16 %5, %16 offset:2304\n\tds_read_b64_tr_b16 %6, %16 offset:192\n\tds_read_b64_tr_b16 %7, %16 offset:2368\n\t" \
    "ds_read_b64_tr_b16 %8, %16 offset:4352\n\tds_read_b64_tr_b16 %9, %16 offset:6528\n\tds_read_b64_tr_b16 %10, %16 offset:4416\n\tds_read_b64_tr_b16 %11, %16 offset:6592\n\t" \
    "ds_read_b64_tr_b16 %12, %16 offset:4480\n\tds_read_b64_tr_b16 %13, %16 offset:6656\n\tds_read_b64_tr_b16 %14, %16 offset:4544\n\tds_read_b64_tr_b16 %15, %16 offset:6720\n\t" \
    "s_waitcnt lgkmcnt(0)" \
    : "=&v"(o[0]), "=&v"(o[1]), "=&v"(o[2]), "=&v"(o[3]), "=&v"(o[4]), "=&v"(o[5]), "=&v"(o[6]), "=&v"(o[7]), "=&v"(o[8]), "=&v"(o[9]), "=&v"(o[10]), "=&v"(o[11]), "=&v"(o[12]), "=&v"(o[13]), "=&v"(o[14]), "=&v"(o[15]) \
    : "v"(a) : "memory")

__device__ void attn_item(const Params& p, int l, int item, unsigned char* smem) {
    const int qt = 16 - item / 32, bl = (item & 31) >> 3, h = item & 7, q0 = qt * 128, m0 = bl * LL;
    const int tid = otid(), w = tid >> 6, lane = tid & 63, l31 = lane & 31, hh = lane >> 5, g2 = w >> 2, wq = w & 3;
    bf16_t* Ks = (bf16_t*)smem; bf16_t* Vs = (bf16_t*)(smem + 17408); float* Ex = (float*)(smem + 34816);
    bf16_t* Z = (bf16_t*)(p.ws + WS_Z);
    const int qrow = q0 + wq * 32 + l31, qr = qrow < LL ? qrow : LL - 1;
    const unsigned vaddr = (unsigned)(unsigned long long)(LAS unsigned char*)(smem + 17408) + (unsigned)((((4 * hh + ((lane & 15) >> 2)) * 136) + 16 * ((lane >> 4) & 1) + 4 * (lane & 3)) * 2);
    bf16x8 qf[4];
    { const bf16_t* qp = Z + (size_t)(m0 + qr) * ZS + C_AQ + h * 128 + g2 * 64 + 8 * hh;
#pragma unroll
        for (int s = 0; s < 4; ++s) qf[s] = *(const bf16x8*)(qp + 16 * s); }
    f32x16 O[4];
#pragma unroll
    for (int v = 0; v < 4; ++v)
#pragma unroll
        for (int r = 0; r < 16; ++r) O[v][r] = 0.f;
    float mrun = -1e30f, lrun = 0.f;
    int nkt = (q0 + 128 + 63) / 64; if (nkt > (LL + 63) / 64) nkt = (LL + 63) / 64;
    u32x4 kreg[2], vreg[2];
#define AT_ISSUE(kt_) do { _Pragma("unroll") for (int e = 0; e < 2; ++e) { const int idx = tid + NTH * e, key = idx >> 4, c16 = idx & 15; int kr = (kt_) * 64 + key; kr = kr < LL ? kr : LL - 1; \
        const bf16_t* zr = Z + (size_t)(m0 + kr) * ZS + h * 128 + c16 * 8; kreg[e] = *(const u32x4*)(zr + C_AK); vreg[e] = *(const u32x4*)(zr + C_AV); } } while (0)
    AT_ISSUE(0);
    for (int kt = 0; kt < nkt; ++kt) {
        const int k0 = kt * 64;
        __syncthreads();
#pragma unroll
        for (int e = 0; e < 2; ++e) { const int idx = tid + NTH * e, key = idx >> 4, c16 = idx & 15; *(u32x4*)(Ks + key * 136 + c16 * 8) = kreg[e]; *(u32x4*)(Vs + key * 136 + c16 * 8) = vreg[e]; }
        if (kt + 1 < nkt) AT_ISSUE(kt + 1);
        __syncthreads();
        f32x16 X[2];
#pragma unroll
        for (int t2 = 0; t2 < 2; ++t2) {
#pragma unroll
            for (int r = 0; r < 16; ++r) X[t2][r] = 0.f;
#pragma unroll
            for (int s = 0; s < 4; ++s) X[t2] = mfma32(*(const bf16x8*)(Ks + (32 * t2 + l31) * 136 + g2 * 64 + 16 * s + 8 * hh), qf[s], X[t2]); }
        float mx = -1e30f;
#pragma unroll
        for (int t2 = 0; t2 < 2; ++t2)
#pragma unroll
            for (int r = 0; r < 16; ++r) { const int key = k0 + 32 * t2 + (r & 3) + 8 * (r >> 2) + 4 * hh; if (key > qrow) X[t2][r] = -1e30f; mx = fmaxf(mx, X[t2][r]); }
        mx = fmaxf(mx, __shfl_xor(mx, 32));
        const float mnew = fmaxf(mrun, mx), alpha = __expf(mrun - mnew); float sm = 0.f;
#pragma unroll
        for (int t2 = 0; t2 < 2; ++t2)
#pragma unroll
            for (int r = 0; r < 16; ++r) { const float e = __expf(X[t2][r] - mnew); X[t2][r] = e; sm += e; }
        sm += __shfl_xor(sm, 32); lrun = lrun * alpha + sm; mrun = mnew;
#pragma unroll
        for (int v = 0; v < 4; ++v)
#pragma unroll
            for (int r = 0; r < 16; ++r) O[v][r] *= alpha;
#pragma unroll
        for (int t2 = 0; t2 < 2; ++t2) { u32x2 o[16]; const unsigned va = vaddr + t2 * 8704; TR16(o, va);
#pragma unroll
            for (int s = 0; s < 2; ++s) { const bf16x8 pb = pack8(X[t2], s);
#pragma unroll
                for (int v = 0; v < 4; ++v) { u32x4 fw; fw.x = o[(s * 4 + v) * 2].x; fw.y = o[(s * 4 + v) * 2].y; fw.z = o[(s * 4 + v) * 2 + 1].x; fw.w = o[(s * 4 + v) * 2 + 1].y;
                    O[v] = mfma32(__builtin_bit_cast(bf16x8, fw), pb, O[v]); } } }
    }
#undef AT_ISSUE
    const float il = 1.0f / lrun; const int ql = wq * 32 + l31;
    if (g2 == 1) {
#pragma unroll
        for (int v = 0; v < 4; ++v)
#pragma unroll
            for (int r4 = 0; r4 < 4; ++r4) { f32x4 o; o[0] = O[v][4 * r4] * il; o[1] = O[v][4 * r4 + 1] * il; o[2] = O[v][4 * r4 + 2] * il; o[3] = O[v][4 * r4 + 3] * il;
                *(f32x4*)(Ex + ql * 132 + 32 * v + 8 * r4 + 4 * hh) = o; }
    }
    __syncthreads();
    if (g2 == 0) {
        float d1 = 0.f, d2 = 0.f;
        for (int j = 0; j < 64; ++j) { d1 += p.lq1[l * 64 + j] * p.lk1[l * 64 + j]; d2 += p.lq2[l * 64 + j] * p.lk2[l * 64 + j]; }
        const float lam_init = 0.8f - 0.6f * expf(-0.3f * (float)l), lam = expf(d1) - expf(d2) + lam_init;
        float ss = 0.f;
#pragma unroll
        for (int v = 0; v < 4; ++v)
#pragma unroll
            for (int r4 = 0; r4 < 4; ++r4) { const f32x4 o2 = *(const f32x4*)(Ex + ql * 132 + 32 * v + 8 * r4 + 4 * hh);
#pragma unroll
                for (int j = 0; j < 4; ++j) { const float o = O[v][4 * r4 + j] * il - lam * o2[j]; O[v][4 * r4 + j] = o; ss += o * o; } }
        ss += __shfl_xor(ss, 32);
        const float rn = rsqrtf(ss * (1.0f / 128.0f) + 1e-6f) * (1.0f - lam_init);
        if (qrow < LL) { bf16_t* zr = Z + (size_t)(m0 + qrow) * ZS + h * 128;
            u32x2 gg[4][4]; f32x4 nwv[4][4];
#pragma unroll
            for (int v = 0; v < 4; ++v)
#pragma unroll
                for (int r4 = 0; r4 < 4; ++r4) { gg[v][r4] = *(const u32x2*)(zr + C_AG + 32 * v + 8 * r4 + 4 * hh); nwv[v][r4] = *(const f32x4*)(p.att_norm_w + l * 128 + 32 * v + 8 * r4 + 4 * hh); }
#pragma unroll
            for (int v = 0; v < 4; ++v)
#pragma unroll
                for (int r4 = 0; r4 < 4; ++r4) { const int vc = 32 * v + 8 * r4 + 4 * hh; const f32x4 nw = nwv[v][r4]; const u32x2 g = gg[v][r4];
                    u32x2 ov; ov.x = pk2(O[v][4 * r4] * rn * nw[0] * silu(lo2f(g.x)), O[v][4 * r4 + 1] * rn * nw[1] * silu(hi2f(g.x)));
                    ov.y = pk2(O[v][4 * r4 + 2] * rn * nw[2] * silu(lo2f(g.y)), O[v][4 * r4 + 3] * rn * nw[3] * silu(hi2f(g.y)));
                    *(u32x2*)(zr + C_AQ + vc) = ov; } }
    }
    __syncthreads();
}

__device__ void post_range(const Params& p, int l, int g, int m0r, int m1r, int mstep) {
    const int tid0 = otid(), wave = tid0 >> 6, lane = tid0 & 63;
    const float* T = (const float*)(p.ws + WS_T); const float* pw = p.post_w + l * DM;
    for (int m = m0r + wave; m < m1r; m += mstep) {
        const int b = g * GB + m / LL, t = m % LL;
        if (l == 1 && t < NMETA) continue;
        const float* h = h_in_row(p, l, b, t);
        float* ho = t < NMETA ? (float*)(p.ws + WS_HM) + ((size_t)b * 16 + t) * DM : p.out + ((size_t)b * SEQ + (t - NMETA)) * DM;
        f32x4 v[4]; float ss = 0.f;
#pragma unroll
        for (int i = 0; i < 4; ++i) { v[i] = *(const f32x4*)(T + (size_t)m * DM + (lane + 64 * i) * 4); ss += v[i][0] * v[i][0] + v[i][1] * v[i][1] + v[i][2] * v[i][2] + v[i][3] * v[i][3]; }
        ss = wsum(ss); const float rn = rsqrtf(ss * (1.0f / DM) + 1e-6f);
#pragma unroll
        for (int i = 0; i < 4; ++i) { const f32x4 w = *(const f32x4*)(pw + (lane + 64 * i) * 4); const f32x4 hv = *(const f32x4*)(h + (lane + 64 * i) * 4);
            f32x4 o; o[0] = hv[0] + v[i][0] * rn * w[0]; o[1] = hv[1] + v[i][1] * rn * w[1]; o[2] = hv[2] + v[i][2] * rn * w[2]; o[3] = hv[3] + v[i][3] * rn * w[3];
            *(f32x4*)(ho + (lane + 64 * i) * 4) = o; }
    }
}


__device__ void post_phase(const Params& p, int l, int g) { post_range(p, l, g, obid() * 8, MG, (int)gridDim.x * 8); }

#define XB_TMO      128
#define XB_XCNT(j)  (256  + 64 * (j))
#define XB_XSUB(j)  (1280 + 64 * (j))
#define XB_XGEN(j)  (2304 + 64 * (j))
#define XB_TOP      3328
#define XB_TOPGEN   3392
#define XCD_BAR_WORDS 3456
#define XB_SPIN_CAP (1u << 22)
__device__ __forceinline__ unsigned xb_ld(unsigned* p)              { return __hip_atomic_load(p, __ATOMIC_RELAXED, __HIP_MEMORY_SCOPE_AGENT); }
__device__ __forceinline__ unsigned xb_add(unsigned* p, unsigned v) { return __hip_atomic_fetch_add(p, v, __ATOMIC_RELAXED, __HIP_MEMORY_SCOPE_AGENT); }
__device__ __forceinline__ unsigned xb_xcc_id() { return (unsigned)__builtin_amdgcn_s_getreg((3 << 11) | 20) & 0xFu; }
#define XB_SPIN(cond, bar) do { unsigned _sp = 0; while (cond) { __builtin_amdgcn_s_sleep(1); \
    if ((++_sp & 255u) == 0u) { if (xb_ld(&(bar)[XB_TMO])) break; if (_sp > XB_SPIN_CAP) { atomicAdd(&(bar)[XB_TMO], 1u); break; } } } } while (0)
struct XcdBarrier { unsigned* bar; unsigned x; volatile LAS unsigned* st; };
__device__ __forceinline__ XcdBarrier xcd_barrier_post(unsigned* bar, volatile LAS unsigned* st) {
    XcdBarrier b; b.bar = bar; b.x = xb_xcc_id(); b.st = st;
    if (threadIdx.x == 0) (void)xb_add(&bar[XB_XCNT(b.x)], 1u);
    return b;
}
__device__ __forceinline__ void xcd_barrier_complete(unsigned* bar, unsigned x, unsigned& nloc, unsigned& nx) {
    const unsigned G = gridDim.x * gridDim.y * gridDim.z;
    unsigned sum, cnt, mine, sp = 0u;
    for (;;) {
        sum = 0u; cnt = 0u; mine = 0u;
#pragma unroll
        for (unsigned j = 0; j < 16; ++j) { const unsigned c = xb_ld(&bar[XB_XCNT(j)]); sum += c; cnt += (c > 0u) ? 1u : 0u; mine = (j == x) ? c : mine; }
        if (sum == G) break;
        __builtin_amdgcn_s_sleep(1);
        if ((++sp & 255u) == 0u) { if (xb_ld(&bar[XB_TMO])) break; if (sp > XB_SPIN_CAP) { atomicAdd(&bar[XB_TMO], 1u); break; } }
    }
    nloc = mine > 0u ? mine : 1u; nx = cnt > 0u ? cnt : 1u;
}
__device__ __forceinline__ void xcd_barrier(const XcdBarrier& b, unsigned* bar_) {
    asm volatile("s_waitcnt vmcnt(0)" ::: "memory");
    __syncthreads();
    if (threadIdx.x == 0) {
        unsigned* bar = bar_; const unsigned bx = xb_xcc_id();
        __builtin_amdgcn_s_waitcnt(0);
        unsigned nloc = b.st[0], nx = b.st[1];
        if (nloc == 0u) { xcd_barrier_complete(bar, bx, nloc, nx); b.st[0] = nloc; b.st[1] = nx; }
        const unsigned old = xb_add(&bar[XB_XSUB(bx)], 1u);
        const unsigned gen = old / nloc;
        if (old + 1u == (gen + 1u) * nloc) {
            __builtin_amdgcn_fence(__ATOMIC_RELEASE, "agent");
            asm volatile("s_waitcnt vmcnt(0)" ::: "memory");
            const unsigned og = xb_add(&bar[XB_TOP], 1u);
            const unsigned tg = og / nx;
            if (og + 1u == (tg + 1u) * nx) xb_add(&bar[XB_TOPGEN], 1u);
            else XB_SPIN(xb_ld(&bar[XB_TOPGEN]) == tg, bar);
            __builtin_amdgcn_fence(__ATOMIC_ACQUIRE, "agent");
            xb_add(&bar[XB_XGEN(bx)], 1u);
            asm volatile("s_waitcnt vmcnt(0)" ::: "memory");
        } else {
            XB_SPIN(xb_ld(&bar[XB_XGEN(bx)]) == gen, bar);
            __builtin_amdgcn_fence(__ATOMIC_ACQUIRE, "agent");
            asm volatile("s_waitcnt vmcnt(0)" ::: "memory");
        }
    }
    __syncthreads();
}

constexpr int NPH = 1 + 2 * NG * 7;
template <int s>
__device__ __forceinline__ void run_stage(const Params& p, int l, int g, unsigned char* smem) {
    bf16_t* Z = (bf16_t*)(p.ws + WS_Z);
    if (s == 0) pn_phase(p, l, g);
    else if (s == 1) { const bf16_t* U = (const bf16_t*)(p.ws + WS_U); const bf16_t* W = (const bf16_t*)(p.ws + WS_WIN) + (size_t)l * ZS * 1024; EpiZ epi{Z, 0};
        if ((gridDim.x & 7) == 0) {
            const int b = obid(), x = b & 7, j = b >> 3;
            const Enum1 en{U, W, x, j, (int)(gridDim.x >> 3)}; gemm_stream(en, epi, 1024, MG, 1024, 16, smem);
        } else for (int u = obid(); u < 33 * 61; u += gridDim.x) gemm_unit(U, 1024, MG, W, 1024, 16, (u % 33) * 256, (u / 33) * 256, smem, epi); }
    else if (s == 2) { rope_phase(p);
        unsigned* ctr = (unsigned*)(p.ws + WS_BAR) + 3520 + 64 * (l * NG + g) + 32;
        volatile LAS unsigned* nxt = (volatile LAS unsigned*)(LAS unsigned char*)(smem + LDS_MAIN + 8);
        for (;;) {
            __syncthreads();
            if (threadIdx.x == 0) *nxt = __hip_atomic_fetch_add(ctr, 1u, __ATOMIC_RELAXED, __HIP_MEMORY_SCOPE_AGENT);
            __syncthreads();
            const int it = (int)*nxt;
            if (it >= 64 * NCH / 8 + 32 * NCH) break;
            if (it < 64 * NCH / 8) { const int tid = otid(), wv = tid >> 6; rwkv_summary(p, l, it * 8 + wv, smem + wv * WLDS, tid & 63); }
            else hgrn_summary(p, l, it - 64 * NCH / 8, smem); } }
    else if (s == 3) {
        unsigned* ctr = (unsigned*)(p.ws + WS_BAR) + 3520 + 64 * (l * NG + g);
        const int lgn = l * NG + g + 1, npn = lgn < 2 * NG ? MG / 32 : 0;
        const int lgp = l * NG + g - 1, npo = lgp >= 0 ? MG / 32 : 0;
        volatile LAS unsigned* nxt = (volatile LAS unsigned*)(LAS unsigned char*)(smem + LDS_MAIN + 8);
        for (;;) {
            __syncthreads();
            if (threadIdx.x == 0) *nxt = __hip_atomic_fetch_add(ctr, 1u, __ATOMIC_RELAXED, __HIP_MEMORY_SCOPE_AGENT);
            __syncthreads();
            const int it = (int)*nxt;
            if (it >= 32 + 32 + 544 + npn + npo) break;
            if (it >= 32 + 32 + 544 + npn) { const int k = it - (32 + 32 + 544 + npn); post_range(p, lgp / NG, lgp % NG, 32 * k, 32 * k + 32, 8); continue; }
            if (it >= 32 + 32 + 544) { const int k = it - (32 + 32 + 544); pn_range(p, lgn / NG, lgn % NG, 32 * k, 32 * k + 32, 8); continue; }
            if (it < 32) { const int tid = otid(), wv = tid >> 6;
                if (wv < 4) rwkv_seq(p, l, it * 2 + (wv >> 1), wv & 1, tid & 63, (float*)smem, wv >> 1, smem + 4096 + wv * 19456);
                else { for (int ci = 0; ci < NCH; ++ci) __builtin_amdgcn_s_barrier(); }
                __syncthreads(); }
            else if (it < 64) hgrn_seq(p, l, it - 32, smem); else attn_item(p, l, it - 64, smem); } }
    else if (s == 4) { const bf16_t* Wl = (const bf16_t*)(p.ws + WS_WOUT + (size_t)l * WOUT_L);
        if ((gridDim.x & 7) == 0) { const int b = obid(), x = b & 7, j = b >> 3;
            const Enum4 en{Z, Wl, x, j, (int)(gridDim.x >> 3)}; EpiGate epi{Z, (bf16_t*)(p.ws + WS_GATED), 0}; gemm_stream(en, epi, ZS, MG, 1024, 16, smem);
        } else for (int u = obid(); u < 3 * 132; u += gridDim.x) { const int br = u / 132, r = u % 132; const int co = br == 0 ? C_AQ : br == 1 ? C_RR : C_HQ; EpiGate epi{Z, (bf16_t*)(p.ws + WS_GATED), br};
            gemm_unit(Z + co, ZS, MG, Wl + (size_t)br * 1024 * 1024, 1024, 16, (r % 33) * 256, (r / 33) * 256, smem, epi); } }
    else if (s == 5) { const bf16_t* Wl = (const bf16_t*)(p.ws + WS_WOUT + (size_t)l * WOUT_L) + 3ull * 1024 * 1024; EpiT epi{(float*)(p.ws + WS_T), 0};
        if ((gridDim.x & 7) == 0) { const int b = obid(), x = b & 7, j = b >> 3;
            const Enum5 en{(const bf16_t*)(p.ws + WS_GATED), Wl, x, j, (int)(gridDim.x >> 3)}; gemm_stream(en, epi, 3072, MG, 3072, 48, smem);
        } else for (int u = obid(); u < 132; u += gridDim.x) gemm_unit((const bf16_t*)(p.ws + WS_GATED), 3072, MG, Wl, 3072, 48, (u % 33) * 256, (u / 33) * 256, smem, epi); }
    else post_phase(p, l, g);
}

__device__ __forceinline__ void interval_a(const Params& p, int lg, unsigned char* smem) {
    const int b = obid(), x = b & 7, j = b >> 3, nj = (int)(gridDim.x >> 3);
    if (lg > 0) { const int lp = (lg - 1) / NG; const bf16_t* Wl = (const bf16_t*)(p.ws + WS_WOUT + (size_t)lp * WOUT_L) + 3ull * 1024 * 1024; EpiT epi{(float*)(p.ws + WS_T), 0};
        const Enum5 en{(const bf16_t*)(p.ws + WS_GATED), Wl, x, j, nj}; gemm_stream(en, epi, 3072, MG, 3072, 48, smem); }
    if (lg < 2 * NG) { const int l = lg / NG; const bf16_t* U = (const bf16_t*)(p.ws + WS_U); const bf16_t* W = (const bf16_t*)(p.ws + WS_WIN) + (size_t)l * ZS * 1024; EpiZ epi{(bf16_t*)(p.ws + WS_Z), 0};
        const Enum1m en{U, W, x, j, nj, (lg > 0 && gridDim.x == 256) ? 1 : 0}; gemm_stream(en, epi, 1024, MG, 1024, 16, smem); }
}

template <int s>
__global__ void __launch_bounds__(NTH, 2) stage_k(Params p, int l, int g) {
    extern __shared__ __attribute__((aligned(16))) unsigned char smem[];
    run_stage<s>(p, l, g, smem);
}
__global__ void __launch_bounds__(NTH, 2) p0_k(Params p) {
    extern __shared__ __attribute__((aligned(16))) unsigned char smem[];
    for (int it = obid(); it < 2 * P0_PER_LAYER + 64; it += gridDim.x) p0_item(p, it, (float*)smem);
}


#if ONE_LAUNCH
__global__ void __launch_bounds__(NTH, 2) mega(Params p) {
    extern __shared__ __attribute__((aligned(16))) unsigned char smem[];
    cg::grid_group grid = cg::this_grid();
    volatile LAS unsigned* st = (volatile LAS unsigned*)(LAS unsigned char*)(smem + LDS_MAIN);
    if (threadIdx.x == 0) { st[0] = 0u; st[1] = 0u; }
    __syncthreads();
    const XcdBarrier xb = xcd_barrier_post((unsigned*)(p.ws + WS_BAR), st);
    for (int it = blockIdx.x; it < 2 * P0_PER_LAYER + 64; it += gridDim.x) { if (gridDim.x == 256 && ((it >= P0_PER_LAYER && it < 2 * P0_PER_LAYER) || it >= 2 * P0_PER_LAYER + 32)) continue; p0_item(p, it, (float*)smem); }
    grid.sync();
    { Params q = p; asm volatile("" : "+s"(q.ws)); run_stage<0>(q, 0, 0, smem); xcd_barrier(xb, (unsigned*)(q.ws + WS_BAR)); }
    for (int lg = 0; lg < 2 * NG; ++lg) {
        const int l = lg / NG, g = lg % NG;
        Params q = p; asm volatile("" : "+s"(q.ws));
        interval_a(q, lg, smem); xcd_barrier(xb, (unsigned*)(q.ws + WS_BAR));
        run_stage<2>(q, l, g, smem); xcd_barrier(xb, (unsigned*)(q.ws + WS_BAR));
        run_stage<3>(q, l, g, smem); xcd_barrier(xb, (unsigned*)(q.ws + WS_BAR));
        run_stage<4>(q, l, g, smem);
        if (gridDim.x == 256 && lg < NG) { const int b = blockIdx.x, j = b >> 3, x = b & 7;
            if (j >= 18) for (int k = (j - 18) * 8 + x; k < 1240; k += 112) { const int idx = lg * 1240 + k; p0_item(p, idx < P0_PER_LAYER ? P0_PER_LAYER + idx : 2 * P0_PER_LAYER + 32 + (idx - P0_PER_LAYER), (float*)smem); } }
        xcd_barrier(xb, (unsigned*)(q.ws + WS_BAR));
    }
    { Params q = p; asm volatile("" : "+s"(q.ws)); interval_a(q, 2 * NG, smem); xcd_barrier(xb, (unsigned*)(q.ws + WS_BAR)); run_stage<6>(q, 1, NG - 1, smem); }
}
#endif

template <int s> static void launch_stage(const Params& p, int l, int g, int grid, hipStream_t stream) {
    static bool attr = false;
    if (!attr) { (void)hipFuncSetAttribute((const void*)stage_k<s>, hipFuncAttributeMaxDynamicSharedMemorySize, LDS_BYTES); attr = true; }
    hipLaunchKernelGGL(stage_k<s>, dim3(grid), dim3(NTH), LDS_BYTES, stream, p, l, g);
}

extern "C" void kernel_launch(void* const* d_in, const int* in_sizes, int n_in, void* d_out, int out_size, void* d_ws, size_t ws_size, hipStream_t stream) {
    static int grid = 0;
    if (grid == 0) {
        if (ws_size < WS_END) { fprintf(stderr, "kernel_launch: workspace too small: %zu < %zu\n", ws_size, (size_t)WS_END); grid = -1; return; }
        int dev = 0, cus = 0;
        (void)hipGetDevice(&dev); (void)hipDeviceGetAttribute(&cus, hipDeviceAttributeMultiprocessorCount, dev);
        (void)hipFuncSetAttribute((const void*)p0_k, hipFuncAttributeMaxDynamicSharedMemorySize, LDS_BYTES);
        grid = cus > 0 ? cus : 256;
        (void)hipGetLastError();
    }
    if (grid < 0) return;
    Params p{};
    p.x = (const float*)d_in[0]; p.meta = (const float*)d_in[1]; p.pre_w = (const float*)d_in[2]; p.post_w = (const float*)d_in[3]; p.w_in = (const float*)d_in[4];
    p.lq1 = (const float*)d_in[5]; p.lk1 = (const float*)d_in[6]; p.lq2 = (const float*)d_in[7]; p.lk2 = (const float*)d_in[8]; p.att_norm_w = (const float*)d_in[9];
    p.mu = (const float*)d_in[10]; p.w0 = (const float*)d_in[11]; p.w_up = (const float*)d_in[12]; p.a0 = (const float*)d_in[13]; p.a_up = (const float*)d_in[14];
    p.k_k = (const float*)d_in[15]; p.k_a = (const float*)d_in[16]; p.r_k = (const float*)d_in[17]; p.gn_w = (const float*)d_in[18]; p.gn_b = (const float*)d_in[19];
    p.hlb = (const float*)d_in[20]; p.hnw = (const float*)d_in[21]; p.w_att_out = (const float*)d_in[22]; p.w_rwkv_out = (const float*)d_in[23]; p.w_hgrn_out = (const float*)d_in[24]; p.w_o = (const float*)d_in[25];
    p.out = (float*)d_out; p.ws = (unsigned char*)d_ws;
#if ONE_LAUNCH
    { static bool attr = false; if (!attr) { (void)hipFuncSetAttribute((const void*)mega, hipFuncAttributeMaxDynamicSharedMemorySize, LDS_BYTES); attr = true; }
      (void)hipMemsetAsync((unsigned char*)d_ws + WS_BAR, 0, 16384, stream);
      void* args[] = {&p};
      hipError_t e = hipLaunchCooperativeKernel((const void*)mega, dim3(grid), dim3(NTH), args, LDS_BYTES, stream);
      if (e != hipSuccess) fprintf(stderr, "cooperative launch failed: %s (grid %d)\n", hipGetErrorString(e), grid); }
#else
    hipLaunchKernelGGL(p0_k, dim3(grid), dim3(NTH), LDS_BYTES, stream, p);
    for (int l = 0; l < 2; ++l)
        for (int g = 0; g < NG; ++g) {
            launch_stage<0>(p, l, g, grid, stream); launch_stage<1>(p, l, g, grid, stream); launch_stage<2>(p, l, g, grid, stream); launch_stage<3>(p, l, g, grid, stream);
            launch_stage<4>(p, l, g, grid, stream); launch_stage<5>(p, l, g, grid, stream); launch_stage<6>(p, l, g, grid, stream);
        }
#endif
}
```
